# Optimizing an MI355X kernel written in HIP

```python
import math
import jax, jax.numpy as jnp
from jax import lax
import numpy as np

D_MODEL = 1024
BATCH = 8
SEQ = 2048
DEPTH = 2

N_META = 16
D_A = D_MODEL // 2
D_B = D_MODEL // 2
CONV_A_WIDTH = 31
POOL_WINDOWS = (2, 4, 8, 16)
N_POOL = len(POOL_WINDOWS)
POOL_C = D_B // N_POOL
D_IN_AB = 2 * D_A + D_B
D_C = D_MODEL
CONV_C_WIDTH = 3
D_IN_C = 3 * D_C
D_FF = 2816
CONV_F_WIDTH = 3
DEEPNORM_ALPHA = (2.0 * DEPTH) ** 0.25
DEEPNORM_BETA = (8.0 * DEPTH) ** -0.25
LN_EPS = 1e-5
N_EVEN = (DEPTH + 1) // 2
N_ODD = DEPTH // 2

kernel_name = "hybrid_conformer_pool_shortconv_encoder"


def layer_norm(x, g, b):
    x32 = x.astype(jnp.float32)
    mu = jnp.mean(x32, axis=-1, keepdims=True)
    var = jnp.mean(jnp.square(x32 - mu), axis=-1, keepdims=True)
    y = (x32 - mu) * lax.rsqrt(var + LN_EPS) * g.astype(jnp.float32) + b.astype(jnp.float32)
    return y.astype(x.dtype)


def dwconv(x, w, b):
    k = w.shape[0]
    pad = k // 2
    y = lax.conv_general_dilated(
        x, w[:, None, :].astype(x.dtype), window_strides=(1,), padding=[(pad, pad)],
        dimension_numbers=("NWC", "WIO", "NWC"), feature_group_count=x.shape[-1])
    return y + b


def multiscale_pool(u):
    bsz, length = u.shape[0], u.shape[1]
    u32 = u.astype(jnp.float32)
    csum = jnp.concatenate(
        [jnp.zeros((bsz, 1) + u.shape[2:], jnp.float32), jnp.cumsum(u32, axis=1)], axis=1)
    t = jnp.arange(length)
    outs = []
    for g, w in enumerate(POOL_WINDOWS):
        lo = jnp.clip(t - w // 2, 0, length)
        hi = jnp.clip(t + (w - w // 2), 0, length)
        s = jnp.take(csum[:, :, g], hi, axis=1) - jnp.take(csum[:, :, g], lo, axis=1)
        cnt = (hi - lo).astype(jnp.float32)
        outs.append(s / cnt[None, :, None] - u32[:, :, g])
    return jnp.stack(outs, axis=2).astype(u.dtype)


def mixer_ab(x, w_in, b_in, conv_w, conv_b, n_g, n_b, pool_w, pool_scale, w_out, b_out):
    bsz, length, _ = x.shape
    h = x @ w_in + b_in
    a_val, a_gate, u_b = jnp.split(h, [D_A, 2 * D_A], axis=-1)
    a = a_val * jax.nn.sigmoid(a_gate)
    a = dwconv(a, conv_w, conv_b)
    a = jax.nn.silu(layer_norm(a, n_g, n_b))
    p = multiscale_pool(u_b.reshape(bsz, length, N_POOL, POOL_C))
    p = jnp.einsum("blgc,gcd->blgd", p, pool_w).reshape(bsz, length, D_B) * pool_scale
    return jnp.concatenate([a, p], axis=-1) @ w_out + b_out


def mixer_c(x, w_in, b_in, conv_w, conv_b, w_out, b_out):
    h = x @ w_in + b_in
    bg, cg, v = jnp.split(h, 3, axis=-1)
    y = bg * dwconv(cg * v, conv_w, conv_b)
    return y @ w_out + b_out


def conv_glu(x, w_up, b_up, conv_w, conv_b, w_down, b_down):
    h = x @ w_up + b_up
    g, v = jnp.split(h, 2, axis=-1)
    g = dwconv(g, conv_w, conv_b)
    return (jax.nn.silu(g) * v) @ w_down + b_down


def setup_inputs(seed: int = 0) -> dict:
    key = jax.random.key(seed)
    ks = iter(jax.random.split(key, 40))
    nrm = lambda shape, s: jax.random.normal(next(ks), shape, jnp.float32) * s
    d = D_MODEL
    return {
        "x": nrm((BATCH, SEQ, d), 1.0),
        "meta_tokens": nrm((N_META, d), 1.0),
        "w_in_ab": nrm((N_EVEN, d, D_IN_AB), d ** -0.5),
        "b_in_ab": nrm((N_EVEN, D_IN_AB), 0.02),
        "conv_a_w": nrm((N_EVEN, CONV_A_WIDTH, D_A), CONV_A_WIDTH ** -0.5),
        "conv_a_b": nrm((N_EVEN, D_A), 0.02),
        "norm_a_g": 1.0 + nrm((N_EVEN, D_A), 0.05),
        "norm_a_b": nrm((N_EVEN, D_A), 0.02),
        "pool_w": nrm((N_EVEN, N_POOL, POOL_C, POOL_C), POOL_C ** -0.5),
        "pool_scale": 1.0 + nrm((N_EVEN, D_B), 0.1),
        "w_out_ab": nrm((N_EVEN, D_A + D_B, d), (D_A + D_B) ** -0.5 * DEEPNORM_BETA),
        "b_out_ab": nrm((N_EVEN, d), 0.02),
        "w_in_c": nrm((N_ODD, d, D_IN_C), d ** -0.5),
        "b_in_c": nrm((N_ODD, D_IN_C), 0.02),
        "conv_c_w": nrm((N_ODD, CONV_C_WIDTH, D_C), CONV_C_WIDTH ** -0.5),
        "conv_c_b": nrm((N_ODD, D_C), 0.02),
        "w_out_c": nrm((N_ODD, D_C, d), D_C ** -0.5 * DEEPNORM_BETA),
        "b_out_c": nrm((N_ODD, d), 0.02),
        "mix_ln_g": 1.0 + nrm((DEPTH, d), 0.05),
        "mix_ln_b": nrm((DEPTH, d), 0.02),
        "ffn_w_up": nrm((DEPTH, d, 2 * D_FF), d ** -0.5),
        "ffn_b_up": nrm((DEPTH, 2 * D_FF), 0.02),
        "ffn_conv_w": nrm((DEPTH, CONV_F_WIDTH, D_FF), CONV_F_WIDTH ** -0.5),
        "ffn_conv_b": nrm((DEPTH, D_FF), 0.02),
        "ffn_w_down": nrm((DEPTH, D_FF, d), D_FF ** -0.5 * DEEPNORM_BETA),
        "ffn_b_down": nrm((DEPTH, d), 0.02),
        "ffn_ln_g": 1.0 + nrm((DEPTH, d), 0.05),
        "ffn_ln_b": nrm((DEPTH, d), 0.02),
    }


def reference(x, meta_tokens, w_in_ab, b_in_ab, conv_a_w, conv_a_b, norm_a_g, norm_a_b,
              pool_w, pool_scale, w_out_ab, b_out_ab, w_in_c, b_in_c, conv_c_w, conv_c_b,
              w_out_c, b_out_c, mix_ln_g, mix_ln_b, ffn_w_up, ffn_b_up, ffn_conv_w,
              ffn_conv_b, ffn_w_down, ffn_b_down, ffn_ln_g, ffn_ln_b):
    bsz = x.shape[0]
    meta = jnp.broadcast_to(meta_tokens[None].astype(x.dtype), (bsz, N_META, x.shape[-1]))
    h = jnp.concatenate([meta, x], axis=1)
    for i in range(DEPTH):
        if i % 2 == 0:
            j = i // 2
            m = mixer_ab(h, w_in_ab[j], b_in_ab[j], conv_a_w[j], conv_a_b[j], norm_a_g[j],
                         norm_a_b[j], pool_w[j], pool_scale[j], w_out_ab[j], b_out_ab[j])
        else:
            j = i // 2
            m = mixer_c(h, w_in_c[j], b_in_c[j], conv_c_w[j], conv_c_b[j], w_out_c[j], b_out_c[j])
        h = layer_norm(DEEPNORM_ALPHA * h + m, mix_ln_g[i], mix_ln_b[i])
        f = conv_glu(h, ffn_w_up[i], ffn_b_up[i], ffn_conv_w[i], ffn_conv_b[i],
                     ffn_w_down[i], ffn_b_down[i])
        h = layer_norm(DEEPNORM_ALPHA * h + f, ffn_ln_g[i], ffn_ln_b[i])
    return h[:, N_META:]
```

```cpp
#include <hip/hip_runtime.h>
#include <hip/hip_cooperative_groups.h>
#include <cstdio>
#include <cstdint>
namespace cg = cooperative_groups;
namespace pg8 {
#define PG8_LAS __attribute__((address_space(3)))
typedef unsigned short bf16_t;
typedef short bf16x8 __attribute__((ext_vector_type(8)));
typedef float f32x4 __attribute__((ext_vector_type(4)));
typedef unsigned u32x4 __attribute__((ext_vector_type(4)));
constexpr int BM = 256, BK = 64, HALF = 128, HTB = HALF * BK * 2  , STAGE_BYTES = 8 * HTB, NXCD = 8, WGM = 8;

__host__ __device__ __forceinline__ int lds_byte(int r, int c) { const int st = (r >> 4) * 2 + (c >> 5), rr = r & 15, cc = c & 31, ob = rr * 64 + cc * 2; return st * 1024 + (ob ^ (((ob >> 9) & 1) << 5)); }
__host__ __device__ __forceinline__ void stage_rc(int b, int& R, int& C) { const int st = b / 1024, sb = b % 1024, swz = sb ^ (((sb >> 9) & 1) << 5); R = (st >> 1) * 16 + swz / 64; C = (st & 1) * 32 + (swz % 64) / 2; }
__host__ __device__ __forceinline__ int perm32(int rho) { const int n = rho >> 4, i = rho & 15; return 8 * (i >> 2) + 4 * n + (i & 3); }

struct Unit { int pm, pn; };
struct Gemm { const bf16_t* A; const bf16_t* Bt; int M, N, K; };

struct StaticOrder {
    int nM, nN, nwg, G, c;
    __host__ __device__ void init(int M, int N, int G_, int c_) { nM = M / BM; nN = N / BM; nwg = nM * nN; G = G_; c = c_; }
    __host__ __device__ bool next(int i, Unit& u) const {
        const long L = (long)i * G + c; if (L >= nwg) return false;
        int wgid = (int)L; { const int q = nwg / NXCD, r = nwg % NXCD, xcd = wgid % NXCD, off = wgid / NXCD; wgid = (xcd < r ? xcd * (q + 1) : r * (q + 1) + (xcd - r) * q) + off; }
        const int nig = WGM * nN, gid = wgid / nig, fm = gid * WGM, gsz = (nM - fm) < WGM ? (nM - fm) : WGM;
        u.pm = fm + ((wgid % nig) % gsz); u.pn = (wgid % nig) / gsz; return true;
    }
    __device__ __forceinline__ void a_ready(const Unit&) const {}
    __device__ __forceinline__ void done(const Unit&) const {}
};
__device__ __forceinline__ unsigned cvt_pk_bf16(float lo, float hi) { unsigned r; asm volatile("v_cvt_pk_bf16_f32 %0, %1, %2" : "=v"(r) : "v"(lo), "v"(hi)); return r; }
__device__ __forceinline__ float bf_lo(unsigned w) { return __uint_as_float(w << 16); }
__device__ __forceinline__ float bf_hi(unsigned w) { return __uint_as_float(w & 0xffff0000u); }

struct EpiBf16 {
    static constexpr bool PERM = true, AFTER_DRAIN = false;
    bf16_t* O; int ldc; const float* bias;
    __device__ __forceinline__ void operator()(const f32x4 (&acc)[2][2][4][2], const Unit& u, int wr, int wc, int fr, int fq) const {
        const int row0 = u.pm * BM + wr * 64 + fr; const int col0 = u.pn * BM + wc * 32 + 8 * fq;
        f32x4 bv[2][2];
#pragma unroll
        for (int bj = 0; bj < 2; ++bj)
#pragma unroll
            for (int n = 0; n < 2; ++n) bv[bj][n] = *(const f32x4*)(bias + col0 + bj * HALF + 4 * n);
#pragma unroll
        for (int ai = 0; ai < 2; ++ai)
#pragma unroll
            for (int m = 0; m < 4; ++m) { bf16_t* rowp = O + (size_t)(row0 + ai * HALF + m * 16) * ldc + col0;
#pragma unroll
                for (int bj = 0; bj < 2; ++bj) { const f32x4 v0 = acc[ai][bj][m][0] + bv[bj][0], v1 = acc[ai][bj][m][1] + bv[bj][1];
                    u32x4 w; w.x = cvt_pk_bf16(v0[0], v0[1]); w.y = cvt_pk_bf16(v0[2], v0[3]); w.z = cvt_pk_bf16(v1[0], v1[1]); w.w = cvt_pk_bf16(v1[2], v1[3]);
                    *(u32x4*)(rowp + bj * HALF) = w; } }
    }
};
template <bool BASE_F32> struct EpiRes {
    static constexpr bool PERM = false, AFTER_DRAIN = false;
    float* Y; const float* bias; const float* x; const float* meta; const bf16_t* xb; float alpha;
    __device__ __forceinline__ void operator()(const f32x4 (&acc)[2][2][4][2], const Unit& u, int wr, int wc, int fr, int fq) const {
        const int row0 = u.pm * BM + wr * 64 + fr, col0 = u.pn * BM + wc * 32 + 4 * fq;
        f32x4 bv[2][2];
#pragma unroll
        for (int bj = 0; bj < 2; ++bj)
#pragma unroll
            for (int n = 0; n < 2; ++n) bv[bj][n] = *(const f32x4*)(bias + col0 + bj * HALF + n * 16);
#pragma unroll
        for (int ai = 0; ai < 2; ++ai)
#pragma unroll
            for (int m = 0; m < 4; ++m) { const int row = row0 + ai * HALF + m * 16; float* rowp = Y + (size_t)row * 1024 + col0;
                if (BASE_F32) { const float* bp = (row < 16384 ? x + (size_t)row * 1024 : meta + (size_t)((row - 16384) & 15) * 1024) + col0;
#pragma unroll
                    for (int bj = 0; bj < 2; ++bj)
#pragma unroll
                        for (int n = 0; n < 2; ++n) { const f32x4 b = *(const f32x4*)(bp + bj * HALF + n * 16); *(f32x4*)(rowp + bj * HALF + n * 16) = acc[ai][bj][m][n] + bv[bj][n] + b * alpha; }
                } else { const bf16_t* bp = xb + (size_t)row * 1024 + col0;
#pragma unroll
                    for (int bj = 0; bj < 2; ++bj)
#pragma unroll
                        for (int n = 0; n < 2; ++n) { const uint2 b = *(const uint2*)(bp + bj * HALF + n * 16); const f32x4 bf = (f32x4){bf_lo(b.x), bf_hi(b.x), bf_lo(b.y), bf_hi(b.y)};
                            *(f32x4*)(rowp + bj * HALF + n * 16) = acc[ai][bj][m][n] + bv[bj][n] + bf * alpha; } }
                asm volatile("" ::: "memory"); }
    }
};

template <class Epi, class Sched, bool STAMP = false>
__device__ __forceinline__ void gemm_phase(PG8_LAS unsigned char* lds, const Gemm g, const Sched& S, const Epi& E, unsigned long long* stamps) {
    int tid = threadIdx.x; asm volatile("" : "+v"(tid));
    const int wid = __builtin_amdgcn_readfirstlane(tid >> 6), lane = tid & 63, wr = wid >> 2, wc = wid & 3, fr = lane & 15, fq = lane >> 4;
    const int K = g.K, nt = K / BK;
    int ts_lo = 0, ts_hi = 0, nts = 0; const unsigned long long rt_entry = STAMP ? (unsigned long long)wall_clock64() : 0ull;
#define PG8_STAMP() do { if (STAMP && wid == 0 && nts < 64) { const unsigned long long _c = (unsigned long long)clock64(); \
        ts_lo = (lane == nts) ? (int)(unsigned)_c : ts_lo; ts_hi = (lane == nts) ? (int)(unsigned)(_c >> 32) : ts_hi; ++nts; } } while (0)
    PG8_STAMP();
    unsigned voffA[2], voffB[2];
#pragma unroll
    for (int i = 0; i < 2; ++i) { int R, C; stage_rc(tid * 16 + i * 8192, R, C); const int Rb = Epi::PERM ? ((R & ~31) + perm32(R & 31)) : R;
        voffA[i] = (unsigned)(R * K + C) * 2u; voffB[i] = (unsigned)(Rb * K + C) * 2u; }
    const size_t kstep = (size_t)(BK * 2);
    const size_t hstep = (size_t)HALF * K * 2;
    const size_t tstep = 2 * hstep;
    const unsigned ldsw = (unsigned)wid * 1024u;
    const int aoff = lds_byte(wr * 64 + fr, fq * 8), boff = lds_byte(wc * 32 + fr, fq * 8);
#define PG8_SA(b, h) (((b) * 2 + (h)) * HTB)
#define PG8_SB(b, h) ((4 + (b) * 2 + (h)) * HTB)
#define PG8_STAGE(bufoff, gbase, voff) do { _Pragma("unroll") for (int _i = 0; _i < 2; ++_i) \
        __builtin_amdgcn_global_load_lds((const unsigned*)((const char*)(gbase) + (voff)[_i]), (PG8_LAS unsigned*)(lds + (bufoff) + ldsw + _i * 8192), 16, 0, 0); } while (0)
#define PG8_LDA(dst, b, h) do { _Pragma("unroll") for (int m = 0; m < 4; ++m) _Pragma("unroll") for (int k = 0; k < 2; ++k) dst[m][k] = *(const PG8_LAS bf16x8*)(lds + PG8_SA(b, h) + aoff + m * 2048 + k * 1024); } while (0)
#define PG8_LDB(dst, b, h) do { _Pragma("unroll") for (int n = 0; n < 2; ++n) _Pragma("unroll") for (int k = 0; k < 2; ++k) dst[n][k] = *(const PG8_LAS bf16x8*)(lds + PG8_SB(b, h) + boff + n * 2048 + k * 1024); } while (0)
#define PG8_MMA(ai, bj, At, Bt) do { __builtin_amdgcn_s_setprio(1); _Pragma("unroll") for (int m = 0; m < 4; ++m) _Pragma("unroll") for (int n = 0; n < 2; ++n) _Pragma("unroll") for (int k = 0; k < 2; ++k) \
        acc[ai][bj][m][n] = __builtin_amdgcn_mfma_f32_16x16x32_bf16(Bt[n][k], At[m][k], acc[ai][bj][m][n], 0, 0, 0); __builtin_amdgcn_s_setprio(0); } while (0)
#define PG8_WAIT_V(n) asm volatile("s_waitcnt vmcnt(" #n ")" ::: "memory")
#define PG8_WAIT_L(n) asm volatile("s_waitcnt lgkmcnt(" #n ")" ::: "memory")
#define PG8_BAR __builtin_amdgcn_s_barrier()
#define PG8_SCHED __builtin_amdgcn_sched_barrier(0)
    Unit cur, nxt; int ui = 0;
    if (!S.next(0, cur)) return;
    f32x4 acc[2][2][4][2];
#pragma unroll
    for (int a = 0; a < 2; ++a)
#pragma unroll
        for (int b = 0; b < 2; ++b)
#pragma unroll
            for (int m = 0; m < 4; ++m)
#pragma unroll
                for (int n = 0; n < 2; ++n) acc[a][b][m][n] = (f32x4){0.f, 0.f, 0.f, 0.f};
    bf16x8 At[4][2], B0[2][2], B1[2][2];
    const char* cA = (const char*)g.A + (size_t)cur.pm * tstep; const char* cB = (const char*)g.Bt + (size_t)cur.pn * tstep;
    S.a_ready(cur);
    PG8_STAGE(PG8_SB(0, 0), cB, voffB); PG8_STAGE(PG8_SA(0, 0), cA, voffA); PG8_STAGE(PG8_SB(0, 1), cB + hstep, voffB); PG8_STAGE(PG8_SA(0, 1), cA + hstep, voffA);
    if (wr == 1) PG8_BAR;
    PG8_WAIT_V(4); PG8_BAR;
    PG8_STAGE(PG8_SB(1, 0), cB + kstep, voffB); PG8_STAGE(PG8_SA(1, 0), cA + kstep, voffA); PG8_STAGE(PG8_SB(1, 1), cB + hstep + kstep, voffB);
    PG8_WAIT_V(6); PG8_BAR;
    PG8_STAMP();
    for (;;) {
        const bool has_next = S.next(ui + 1, nxt);
        const char* nA = has_next ? (const char*)g.A + (size_t)nxt.pm * tstep : cA; const char* nB = has_next ? (const char*)g.Bt + (size_t)nxt.pn * tstep : cB;
#pragma unroll 1
        for (int t = 0; t < nt; t += 2) {
            const bool last = (t == nt - 2);
            const char* a1 = cA + (size_t)(t + 1) * kstep;
            const char* a2 = last ? nA : cA + (size_t)(t + 2) * kstep; const char* b2 = last ? nB : cB + (size_t)(t + 2) * kstep;
            const char* a3 = a2 + kstep; const char* b3 = b2 + kstep;
            if (last && has_next) S.a_ready(nxt);
            PG8_LDB(B0, 0, 0); PG8_SCHED; PG8_LDA(At, 0, 0); PG8_STAGE(PG8_SA(1, 1), a1 + hstep, voffA);
            PG8_WAIT_L(8); PG8_BAR; PG8_WAIT_L(0); PG8_MMA(0, 0, At, B0); PG8_BAR; PG8_SCHED;
            PG8_LDB(B1, 0, 1); PG8_STAGE(PG8_SB(0, 0), b2, voffB);
            PG8_BAR; PG8_WAIT_L(0); PG8_MMA(0, 1, At, B1); PG8_BAR;
            PG8_LDA(At, 0, 1); PG8_STAGE(PG8_SA(0, 0), a2, voffA);
            PG8_BAR; PG8_WAIT_L(0); PG8_MMA(1, 0, At, B0); PG8_BAR; PG8_SCHED;
            PG8_STAGE(PG8_SB(0, 1), b2 + hstep, voffB);
            PG8_WAIT_V(6); PG8_BAR; PG8_MMA(1, 1, At, B1); PG8_BAR;
            PG8_LDB(B0, 1, 0); PG8_SCHED; PG8_LDA(At, 1, 0); PG8_STAGE(PG8_SA(0, 1), a2 + hstep, voffA);
            PG8_WAIT_L(8); PG8_BAR; PG8_WAIT_L(0); PG8_MMA(0, 0, At, B0); PG8_BAR; PG8_SCHED;
            PG8_LDB(B1, 1, 1); PG8_STAGE(PG8_SB(1, 0), b3, voffB);
            PG8_BAR; PG8_WAIT_L(0); PG8_MMA(0, 1, At, B1); PG8_BAR;
            PG8_LDA(At, 1, 1); PG8_STAGE(PG8_SA(1, 0), a3, voffA);
            PG8_BAR; PG8_WAIT_L(0); PG8_MMA(1, 0, At, B0); PG8_BAR; PG8_SCHED;
            PG8_STAGE(PG8_SB(1, 1), b3 + hstep, voffB);
            PG8_WAIT_V(6); PG8_BAR; PG8_MMA(1, 1, At, B1); PG8_BAR;
        }
        PG8_STAMP();
        if constexpr (!Epi::AFTER_DRAIN) { E(acc, cur, wr, wc, fr, fq); S.done(cur); }
        PG8_STAMP();
        if (!has_next) break;
#pragma unroll
        for (int a = 0; a < 2; ++a)
#pragma unroll
            for (int b = 0; b < 2; ++b)
#pragma unroll
                for (int m = 0; m < 4; ++m)
#pragma unroll
                    for (int n = 0; n < 2; ++n) acc[a][b][m][n] = (f32x4){0.f, 0.f, 0.f, 0.f};
        cur = nxt; cA = nA; cB = nB; ++ui;
    }
    PG8_WAIT_V(0);
    if (wr == 0) PG8_BAR;
    PG8_BAR;
    if constexpr (Epi::AFTER_DRAIN) { E.fused(acc, cur, wr, wc, fr, fq, lds, wid, lane); S.done(cur); }
    PG8_STAMP();
    if (STAMP && wid == 0) { stamps[lane] = lane < nts ? (((unsigned long long)(unsigned)ts_hi << 32) | (unsigned)ts_lo) : 0ull;
        if (lane == 62) stamps[62] = rt_entry; if (lane == 63) stamps[63] = (unsigned long long)wall_clock64(); }
#undef PG8_STAMP
#undef PG8_SA
#undef PG8_SB
#undef PG8_STAGE
#undef PG8_LDA
#undef PG8_LDB
#undef PG8_MMA
#undef PG8_WAIT_V
#undef PG8_WAIT_L
#undef PG8_BAR
#undef PG8_SCHED
}
}
#define LAS __attribute__((address_space(3)))
typedef pg8::bf16_t bf16_t;
typedef pg8::f32x4 f32x4;
constexpr int D = 1024, NB = 8, SEQ = 2048, NMETA = 16, LTOK = SEQ + NMETA;
constexpr int MMAIN = NB * SEQ, MMETA = NB * NMETA, MREAL = MMAIN + MMETA, MP = 16640;
constexpr int NINAB = 1536, NINC = 3072, DFF = 2816, NUP = 5632, HUP = 2816, HCH = 1408;
constexpr float ALPHA = 1.41421356237309515f, LN_EPS = 1e-5f;
constexpr size_t MiB = 1u << 20;
constexpr size_t WS_BUP = 0;
constexpr size_t WS_W_INAB = 1 * MiB, WS_W_OUTAB = 4 * MiB, WS_W_INC = 6 * MiB, WS_W_OUTC = 12 * MiB, WS_W_UP = 14 * MiB, WS_W_DN = 36 * MiB;
constexpr size_t SZ_W_UP = (size_t)NUP * D * 2, SZ_W_DN = (size_t)D * DFF * 2;
constexpr size_t WS_R1 = 48 * MiB, WS_R2 = 146 * MiB, WS_END = 236 * MiB;
static_assert(WS_W_DN + 2 * SZ_W_DN <= WS_R1 && WS_R1 + (size_t)MP * 3072 * 2 <= WS_R2 && WS_R2 + (size_t)MP * DFF * 2 <= WS_END, "ws map");
constexpr int LDS_BYTES = 147456;

__device__ __forceinline__ int row_of(int b, int t) { return t < NMETA ? MMAIN + b * NMETA + t : b * SEQ + (t - NMETA); }
__device__ __forceinline__ float sigmoidf_(float x) { return 1.0f / (1.0f + __expf(-x)); }
__device__ __forceinline__ float siluf_(float x) { return x / (1.0f + __expf(-x)); }
__device__ __forceinline__ unsigned f2bf(float f) { unsigned u = __float_as_uint(f); return (u + 0x7fffu + ((u >> 16) & 1u)) >> 16; }
__device__ __forceinline__ unsigned pk2(float lo, float hi) { return f2bf(lo) | (f2bf(hi) << 16); }
__device__ __forceinline__ float bflo(unsigned w) { return __uint_as_float(w << 16); }
__device__ __forceinline__ float bfhi(unsigned w) { return __uint_as_float(w & 0xffff0000u); }
__device__ __forceinline__ float bf1(const bf16_t* p) { return __uint_as_float(((unsigned)*p) << 16); }
__device__ __forceinline__ float wave_sum(float v) {
#pragma unroll
    for (int o = 1; o < 64; o <<= 1) v += __shfl_xor(v, o);
    return v;
}
__device__ __forceinline__ int opaque_tid() { int t = threadIdx.x; asm volatile("" : "+v"(t)); return t; }
__device__ __forceinline__ int opaque_bid() { int t = blockIdx.x; asm volatile("" : "+s"(t)); return t; }
#define UNPACK8(v, f) do { f[0] = bflo(v.x); f[1] = bfhi(v.x); f[2] = bflo(v.y); f[3] = bfhi(v.y); f[4] = bflo(v.z); f[5] = bfhi(v.z); f[6] = bflo(v.w); f[7] = bfhi(v.w); } while (0)

struct Args { const float* in[28]; float* out; unsigned char* ws; };
enum { I_X = 0, I_META, I_W_IN_AB, I_B_IN_AB, I_CONV_A_W, I_CONV_A_B, I_NORM_A_G, I_NORM_A_B, I_POOL_W, I_POOL_SCALE, I_W_OUT_AB, I_B_OUT_AB, I_W_IN_C, I_B_IN_C, I_CONV_C_W, I_CONV_C_B,
       I_W_OUT_C, I_B_OUT_C, I_MIX_LN_G, I_MIX_LN_B, I_FFN_W_UP, I_FFN_B_UP, I_FFN_CONV_W, I_FFN_CONV_B, I_FFN_W_DOWN, I_FFN_B_DOWN, I_FFN_LN_G, I_FFN_LN_B };

__device__ __forceinline__ void transpose_item(const float* W, int ldw, int k0, int n0, bf16_t* dst, int ldo, LAS float* scr, int lane) {
#pragma unroll 8
    for (int i = 0; i < 32; ++i) { const int kk = 2 * i + (lane >> 5); scr[kk * 33 + (lane & 31)] = W[(size_t)(k0 + kk) * ldw + n0 + (lane & 31)]; }
    asm volatile("s_waitcnt lgkmcnt(0)" ::: "memory");
    const int c = lane & 7;
#pragma unroll
    for (int j = 0; j < 4; ++j) { const int n = (lane >> 3) + 8 * j; const LAS float* s = scr + (8 * c) * 33 + n;
        uint4 o; o.x = pk2(s[0 * 33], s[1 * 33]); o.y = pk2(s[2 * 33], s[3 * 33]); o.z = pk2(s[4 * 33], s[5 * 33]); o.w = pk2(s[6 * 33], s[7 * 33]);
        *(uint4*)(dst + (size_t)n * ldo + 8 * c) = o; }
    asm volatile("s_waitcnt lgkmcnt(0)" ::: "memory");
}
__device__ __forceinline__ void phase_prep(const Args& a, LAS unsigned char* lds) {
    const int tid = opaque_tid(), lane = tid & 63, wave = tid >> 6, bid = opaque_bid();
    const int gw = bid * 8 + wave, NGW = gridDim.x * 8;
    unsigned char* ws = a.ws;
    LAS float* scr = (LAS float*)(lds + wave * 16384);
    bf16_t* W_INAB = (bf16_t*)(ws + WS_W_INAB); bf16_t* W_OUTAB = (bf16_t*)(ws + WS_W_OUTAB); bf16_t* W_INC = (bf16_t*)(ws + WS_W_INC); bf16_t* W_OUTC = (bf16_t*)(ws + WS_W_OUTC);
    constexpr int N1 = 16 * 48, N2 = 8 * 32, N3 = 16 * 96, N4 = 16 * 32, N5 = 16 * 176, N6 = 44 * 32;
    constexpr int NITEMS = N1 + N2 + N3 + N4 + 2 * N5 + 2 * N6;
    for (int it = gw; it < NITEMS; it += NGW) {
        int r = it;
        if (r < N1) { const int kb = r / 48, nb = r % 48; transpose_item(a.in[I_W_IN_AB], NINAB, 64 * kb, 32 * nb, W_INAB + (size_t)(32 * nb) * D + 64 * kb, D, scr, lane); continue; } r -= N1;
        if (r < N2) { const int kb = r / 32, nb = r % 32; transpose_item(a.in[I_W_OUT_AB], D, 64 * kb, 32 * nb, W_OUTAB + (size_t)(32 * nb) * D + 64 * kb, D, scr, lane); continue; } r -= N2;
        if (r < N3) { const int kb = r / 96, nb = r % 96; transpose_item(a.in[I_W_IN_C], NINC, 64 * kb, 32 * nb, W_INC + (size_t)(32 * nb) * D + 64 * kb, D, scr, lane); continue; } r -= N3;
        if (r < N4) { const int kb = r / 32, nb = r % 32; transpose_item(a.in[I_W_OUT_C], D, 64 * kb, 32 * nb, W_OUTC + (size_t)(32 * nb) * D + 64 * kb, D, scr, lane); continue; } r -= N4;
        if (r < 2 * N5) { const int l = r / N5; r -= l * N5; const int kb = r / 176, nb = r % 176; const int n0 = 32 * nb;
            const int ch = n0 < DFF ? n0 : n0 - DFF; const int orow = 256 * (ch >> 7) + (n0 < DFF ? 0 : 128) + (ch & 127);
            transpose_item(a.in[I_FFN_W_UP] + (size_t)l * D * NUP, NUP, 64 * kb, n0, (bf16_t*)(ws + WS_W_UP + l * SZ_W_UP) + (size_t)orow * D + 64 * kb, D, scr, lane); continue; } r -= 2 * N5;
        { const int l = r / N6; r -= l * N6; const int kb = r / 32, nb = r % 32;
            transpose_item(a.in[I_FFN_W_DOWN] + (size_t)l * DFF * D, D, 64 * kb, 32 * nb, (bf16_t*)(ws + WS_W_DN + l * SZ_W_DN) + (size_t)(32 * nb) * DFF + 64 * kb, DFF, scr, lane); }
    }
    { const float* pw = a.in[I_POOL_W]; const float* ps = a.in[I_POOL_SCALE]; const float* wo = a.in[I_W_OUT_AB];
      for (int idx = bid * 512 + tid; idx < 1024 * 512; idx += gridDim.x * 512) { const int kq = idx & 511, n = idx >> 9, g = kq >> 7;
          const float* pr = pw + (size_t)kq * 128; float s = 0.f;
#pragma unroll 8
          for (int d = 0; d < 128; ++d) s += pr[d] * (ps[g * 128 + d] * wo[(size_t)(512 + g * 128 + d) * D + n]);
          W_OUTAB[(size_t)n * D + 512 + kq] = (bf16_t)f2bf(s); } }
    { float* bup = (float*)(ws + WS_BUP);
      for (int idx = bid * 512 + tid; idx < 2 * NUP; idx += gridDim.x * 512) { const int l = idx / NUP, c = idx % NUP, j = c >> 8, bj = (c >> 7) & 1, i = c & 127;
          bup[idx] = a.in[I_FFN_B_UP][l * NUP + (bj ? DFF : 0) + 128 * j + i]; } }
    { bf16_t* XB = (bf16_t*)a.out;
      for (int m = gw; m < MP; m += NGW) { uint2* o8 = (uint2*)(XB + (size_t)m * D) + lane;
          if (m < MREAL) { const float* src = m < MMAIN ? a.in[I_X] + (size_t)m * D : a.in[I_META] + (size_t)((m - MMAIN) & 15) * D; const f32x4* xr = (const f32x4*)src + lane;
#pragma unroll
              for (int j = 0; j < 4; ++j) { const f32x4 v = xr[64 * j]; o8[64 * j] = make_uint2(pk2(v.x, v.y), pk2(v.z, v.w)); } }
          else {
#pragma unroll
              for (int j = 0; j < 4; ++j) o8[64 * j] = make_uint2(0u, 0u); } } }
}

__device__ __forceinline__ void phase_mixer0(const Args& a, LAS unsigned char* lds, const bf16_t* Hab, bf16_t* AP) {
    constexpr int T = 34, NT = 61;
    const int tid = opaque_tid(), lane = tid & 63, wave = tid >> 6, bid = opaque_bid();
    LAS float* la = (LAS float*)lds;
    LAS float* part = (LAS float*)(lds + 131072);
    LAS float* stat = (LAS float*)(lds + 131072 + 2304);
    float w[31];
#pragma unroll
    for (int j = 0; j < 31; ++j) w[j] = a.in[I_CONV_A_W][j * 512 + tid];
    const float cb = a.in[I_CONV_A_B][tid], ng = a.in[I_NORM_A_G][tid], nbb = a.in[I_NORM_A_B][tid];
    for (int item = bid; item < NB * NT; item += gridDim.x) {
        const int b = item / NT, t0 = (item % NT) * T;
        __syncthreads();
#pragma unroll
        for (int i = 0; i < 8; ++i) { const int q = tid + 512 * i, j = q >> 6, c8 = q & 63, pos = t0 - 15 + j;
            float av[8];
#pragma unroll
            for (int e = 0; e < 8; ++e) av[e] = 0.f;
            if (pos >= 0 && pos < LTOK) { const bf16_t* rp = Hab + (size_t)row_of(b, pos) * NINAB + 8 * c8; const uint4 vv = *(const uint4*)rp, gg = *(const uint4*)(rp + 512);
                float fv[8], fg[8]; UNPACK8(vv, fv); UNPACK8(gg, fg);
#pragma unroll
                for (int e = 0; e < 8; ++e) av[e] = fv[e] * sigmoidf_(fg[e]); }
            LAS f32x4* dst = (LAS f32x4*)(la + j * 512 + 8 * c8); dst[0] = (f32x4){av[0], av[1], av[2], av[3]}; dst[1] = (f32x4){av[4], av[5], av[6], av[7]}; }
        __syncthreads();
        float o[T];
#pragma unroll
        for (int p = 0; p < T; ++p) { float acc = cb;
#pragma unroll
            for (int j = 0; j < 31; ++j) acc += w[j] * la[(p + j) * 512 + tid];
            o[p] = acc; }
#pragma unroll
        for (int p = 0; p < T; ++p) { const float s1 = wave_sum(o[p]), s2 = wave_sum(o[p] * o[p]); if (lane == 0) { part[(p * 8 + wave) * 2] = s1; part[(p * 8 + wave) * 2 + 1] = s2; } }
        __syncthreads();
        if (tid < T) { float s1 = 0.f, s2 = 0.f;
#pragma unroll
            for (int k = 0; k < 8; ++k) { s1 += part[(tid * 8 + k) * 2]; s2 += part[(tid * 8 + k) * 2 + 1]; }
            const float mean = s1 * (1.f / 512.f); float var = s2 * (1.f / 512.f) - mean * mean; var = var > 0.f ? var : 0.f;
            stat[2 * tid] = mean; stat[2 * tid + 1] = 1.0f / sqrtf(var + LN_EPS); }
        __syncthreads();
#pragma unroll
        for (int p = 0; p < T; ++p) { const int t = t0 + p;
            if (t < LTOK) { const float y = (o[p] - stat[2 * p]) * stat[2 * p + 1] * ng + nbb; AP[(size_t)row_of(b, t) * D + tid] = (bf16_t)f2bf(siluf_(y)); } }
        { const int half = 1 << (tid >> 7); const bf16_t* U = Hab + 1024 + tid;
          const int tend = (t0 + T < LTOK) ? t0 + T : LTOK;
          int lo = t0 - half; lo = lo < 0 ? 0 : lo; int hi = t0 + half; hi = hi > LTOK ? LTOK : hi;
          float s = 0.f;
          for (int q = lo; q < hi; ++q) s += bf1(U + (size_t)row_of(b, q) * NINAB);
          for (int t = t0; t < tend; ++t) {
              int l2 = t - half; l2 = l2 < 0 ? 0 : l2; int h2 = t + half; h2 = h2 > LTOK ? LTOK : h2;
              const float ut = bf1(U + (size_t)row_of(b, t) * NINAB);
              AP[(size_t)row_of(b, t) * D + 512 + tid] = (bf16_t)f2bf(s / (float)(h2 - l2) - ut);
              if (t + half < LTOK) s += bf1(U + (size_t)row_of(b, t + half) * NINAB);
              if (t - half >= 0) s -= bf1(U + (size_t)row_of(b, t - half) * NINAB);
          } }
    }
}

__device__ __forceinline__ void phase_act(const Args& a, const bf16_t* U, bf16_t* ACT, int l, int h) {
    const float* cw = a.in[I_FFN_CONV_W] + (size_t)l * 3 * DFF; const float* cbp = a.in[I_FFN_CONV_B] + (size_t)l * DFF;
    const int nth = gridDim.x * 512;
    for (int idx = opaque_bid() * 512 + opaque_tid(); idx < MREAL * 176; idx += nth) {
        const int r = idx / 176, q = idx - r * 176, b = r / LTOK, t = r - b * LTOK;
        const int jt = q >> 4, i8 = (q & 15) * 8, gcol = 256 * jt + i8, ch = HCH * h + 128 * jt + i8;
        const int row = row_of(b, t);
        const bf16_t* up = U + (size_t)row * HUP + gcol;
        const uint4 g0v = *(const uint4*)up, vv = *(const uint4*)(up + 128);
        uint4 gmv = make_uint4(0, 0, 0, 0), gpv = make_uint4(0, 0, 0, 0);
        if (t > 0) gmv = *(const uint4*)(U + (size_t)row_of(b, t - 1) * HUP + gcol);
        if (t < LTOK - 1) gpv = *(const uint4*)(U + (size_t)row_of(b, t + 1) * HUP + gcol);
        float g0[8], gm[8], gp[8], v[8]; UNPACK8(g0v, g0); UNPACK8(gmv, gm); UNPACK8(gpv, gp); UNPACK8(vv, v);
        float w0[8], w1[8], w2[8], cb[8];
        *(f32x4*)&w0[0] = *(const f32x4*)(cw + ch); *(f32x4*)&w0[4] = *(const f32x4*)(cw + ch + 4);
        *(f32x4*)&w1[0] = *(const f32x4*)(cw + DFF + ch); *(f32x4*)&w1[4] = *(const f32x4*)(cw + DFF + ch + 4);
        *(f32x4*)&w2[0] = *(const f32x4*)(cw + 2 * DFF + ch); *(f32x4*)&w2[4] = *(const f32x4*)(cw + 2 * DFF + ch + 4);
        *(f32x4*)&cb[0] = *(const f32x4*)(cbp + ch); *(f32x4*)&cb[4] = *(const f32x4*)(cbp + ch + 4);
        float o[8];
#pragma unroll
        for (int e = 0; e < 8; ++e) o[e] = siluf_(w0[e] * gm[e] + w1[e] * g0[e] + w2[e] * gp[e] + cb[e]) * v[e];
        uint4 ov; ov.x = pk2(o[0], o[1]); ov.y = pk2(o[2], o[3]); ov.z = pk2(o[4], o[5]); ov.w = pk2(o[6], o[7]);
        *(uint4*)(ACT + (size_t)row * DFF + ch) = ov;
    }
}

__device__ __forceinline__ void phase_yc(const Args& a, const bf16_t* Hc, bf16_t* YC) {
    const float* cw = a.in[I_CONV_C_W]; const float* cbp = a.in[I_CONV_C_B];
    const int nth = gridDim.x * 512;
    for (int idx = opaque_bid() * 512 + opaque_tid(); idx < MREAL * 128; idx += nth) {
        const int r = idx >> 7, c8 = (idx & 127) * 8, b = r / LTOK, t = r - b * LTOK;
        const int row = row_of(b, t);
        const bf16_t* hp = Hc + (size_t)row * NINC + c8;
        const uint4 bgv = *(const uint4*)hp, c0v = *(const uint4*)(hp + 1024), v0v = *(const uint4*)(hp + 2048);
        uint4 cmv = make_uint4(0, 0, 0, 0), vmv = cmv, cpv = cmv, vpv = cmv;
        if (t > 0) { const bf16_t* p = Hc + (size_t)row_of(b, t - 1) * NINC + c8; cmv = *(const uint4*)(p + 1024); vmv = *(const uint4*)(p + 2048); }
        if (t < LTOK - 1) { const bf16_t* p = Hc + (size_t)row_of(b, t + 1) * NINC + c8; cpv = *(const uint4*)(p + 1024); vpv = *(const uint4*)(p + 2048); }
        float bg[8], c0[8], v0[8], cm[8], vm[8], cp[8], vp[8];
        UNPACK8(bgv, bg); UNPACK8(c0v, c0); UNPACK8(v0v, v0); UNPACK8(cmv, cm); UNPACK8(vmv, vm); UNPACK8(cpv, cp); UNPACK8(vpv, vp);
        float w0[8], w1[8], w2[8], cb[8];
        *(f32x4*)&w0[0] = *(const f32x4*)(cw + c8); *(f32x4*)&w0[4] = *(const f32x4*)(cw + c8 + 4);
        *(f32x4*)&w1[0] = *(const f32x4*)(cw + D + c8); *(f32x4*)&w1[4] = *(const f32x4*)(cw + D + c8 + 4);
        *(f32x4*)&w2[0] = *(const f32x4*)(cw + 2 * D + c8); *(f32x4*)&w2[4] = *(const f32x4*)(cw + 2 * D + c8 + 4);
        *(f32x4*)&cb[0] = *(const f32x4*)(cbp + c8); *(f32x4*)&cb[4] = *(const f32x4*)(cbp + c8 + 4);
        float o[8];
#pragma unroll
        for (int e = 0; e < 8; ++e) o[e] = bg[e] * (w0[e] * (cm[e] * vm[e]) + w1[e] * (c0[e] * v0[e]) + w2[e] * (cp[e] * vp[e]) + cb[e]);
        uint4 ov; ov.x = pk2(o[0], o[1]); ov.y = pk2(o[2], o[3]); ov.z = pk2(o[4], o[5]); ov.w = pk2(o[6], o[7]);
        *(uint4*)(YC + (size_t)row * D + c8) = ov;
    }
}

template <bool FINAL> __device__ __forceinline__ void phase_ln(const float* Y, const float* g, const float* bta, bf16_t* XB, float* out) {
    const int tid = opaque_tid(), lane = tid & 63, wave = tid >> 6, gw = opaque_bid() * 8 + wave, NGW = gridDim.x * 8;
    asm volatile("" ::: "memory");
    const int nrows = FINAL ? MMAIN : MREAL;
    for (int m = gw; m < nrows; m += NGW) {
        const f32x4* yr = (const f32x4*)(Y + (size_t)m * D) + lane;
        f32x4 v[4]; float s = 0.f;
#pragma unroll
        for (int j = 0; j < 4; ++j) { v[j] = yr[64 * j]; s += (v[j].x + v[j].y) + (v[j].z + v[j].w); }
        const float mean = wave_sum(s) * (1.f / D); float s2 = 0.f;
#pragma unroll
        for (int j = 0; j < 4; ++j) { v[j] = v[j] - mean; s2 += (v[j].x * v[j].x + v[j].y * v[j].y) + (v[j].z * v[j].z + v[j].w * v[j].w); }
        const float rstd = 1.f / sqrtf(wave_sum(s2) * (1.f / D) + LN_EPS);
        if (FINAL) { f32x4* o = (f32x4*)(out + (size_t)m * D) + lane;
#pragma unroll
            for (int j = 0; j < 4; ++j) o[64 * j] = v[j] * rstd * ((const f32x4*)g)[lane + 64 * j] + ((const f32x4*)bta)[lane + 64 * j]; }
        else { uint2* o8 = (uint2*)(XB + (size_t)m * D) + lane;
#pragma unroll
            for (int j = 0; j < 4; ++j) { const f32x4 y = v[j] * rstd * ((const f32x4*)g)[lane + 64 * j] + ((const f32x4*)bta)[lane + 64 * j]; o8[64 * j] = make_uint2(pk2(y.x, y.y), pk2(y.z, y.w)); } }
    }
}

template <class Epi> __device__ __forceinline__ void run_gemm(LAS unsigned char* lds, const bf16_t* A, const bf16_t* Bt, int N, int K, const Epi& E) {
    asm volatile("" : "+s"(N), "+s"(K));
    pg8::Gemm g{A, Bt, MP, N, K}; pg8::StaticOrder S; S.init(MP, N, (int)gridDim.x, opaque_bid());
#ifndef SKIP_GEMM
#ifdef SKIP_RES
    if constexpr (Epi::PERM)
#endif
#ifdef SKIP_BF
    if constexpr (!Epi::PERM)
#endif
    pg8::gemm_phase<Epi, pg8::StaticOrder, false>(lds, g, S, E, nullptr);
#endif
}

__global__ void __launch_bounds__(512, 2) fwd_kernel(Args a) {
    extern __shared__ __attribute__((aligned(16))) unsigned char lds_raw[];
    LAS unsigned char* lds = (LAS unsigned char*)lds_raw;
    cg::grid_group grid = cg::this_grid();
    unsigned char* ws = a.ws;
    bf16_t* XB = (bf16_t*)a.out;
    bf16_t* R1b = (bf16_t*)(ws + WS_R1); float* Y = (float*)(ws + WS_R1); bf16_t* R2b = (bf16_t*)(ws + WS_R2);
    const float* bup = (const float*)(ws + WS_BUP);

#ifndef SKIP_PREP
    phase_prep(a, lds);
#endif
    grid.sync();
    { pg8::EpiBf16 E{R1b, NINAB, a.in[I_B_IN_AB]}; run_gemm(lds, XB, (const bf16_t*)(ws + WS_W_INAB), NINAB, D, E); }
    grid.sync();
#ifndef SKIP_MIX
    phase_mixer0(a, lds, R1b, R2b);
#endif
    grid.sync();
    { pg8::EpiRes<true> E{Y, a.in[I_B_OUT_AB], a.in[I_X], a.in[I_META], XB, ALPHA}; run_gemm(lds, R2b, (const bf16_t*)(ws + WS_W_OUTAB), D, D, E); }
    grid.sync();
#ifndef SKIP_LN
    phase_ln<false>(Y, a.in[I_MIX_LN_G], a.in[I_MIX_LN_B], XB, nullptr);
#endif
    grid.sync();
#pragma unroll 1
    for (int l = 0; l < 2; ++l) {
        if (l == 1) {
            { pg8::EpiBf16 E{R1b, NINC, a.in[I_B_IN_C]}; run_gemm(lds, XB, (const bf16_t*)(ws + WS_W_INC), NINC, D, E); }
            grid.sync();
#ifndef SKIP_YC
            phase_yc(a, R1b, R2b);
#endif
            grid.sync();
            { pg8::EpiRes<false> E{Y, a.in[I_B_OUT_C], nullptr, nullptr, XB, ALPHA}; run_gemm(lds, R2b, (const bf16_t*)(ws + WS_W_OUTC), D, D, E); }
            grid.sync();
#ifndef SKIP_LN
            phase_ln<false>(Y, a.in[I_MIX_LN_G] + D, a.in[I_MIX_LN_B] + D, XB, nullptr);
#endif
            grid.sync();
        }
#pragma unroll 1
        for (int h = 0; h < 2; ++h) {
            { pg8::EpiBf16 E{R1b, HUP, bup + l * NUP + h * HUP}; run_gemm(lds, XB, (const bf16_t*)(ws + WS_W_UP + l * SZ_W_UP) + (size_t)h * HUP * D, HUP, D, E); }
            grid.sync();
#ifndef SKIP_ACT
            phase_act(a, R1b, R2b, l, h);
#endif
            grid.sync();
        }
        { pg8::EpiRes<false> E{Y, a.in[I_FFN_B_DOWN] + l * D, nullptr, nullptr, XB, ALPHA}; run_gemm(lds, R2b, (const bf16_t*)(ws + WS_W_DN + l * SZ_W_DN), D, DFF, E); }
        grid.sync();
#ifndef SKIP_LN
        if (l == 0) { phase_ln<false>(Y, a.in[I_FFN_LN_G], a.in[I_FFN_LN_B], XB, nullptr); grid.sync(); }
        else phase_ln<true>(Y, a.in[I_FFN_LN_G] + D, a.in[I_FFN_LN_B] + D, nullptr, a.out);
#endif
    }
}

extern "C" void kernel_launch(void* const* d_in, const int* in_sizes, int n_in, void* d_out, int out_size, void* d_ws, size_t ws_size, hipStream_t stream) {
    static int grid_blocks = 0;
    if (!grid_blocks) {
        if (n_in != 28 || out_size != MMAIN * D || ws_size < WS_END) { fprintf(stderr, "kernel_launch: unexpected shapes: n_in %d out %d ws %zu\n", n_in, out_size, ws_size); grid_blocks = -1; return; }
        int dev = 0, cus = 0, per_cu = 0;
        hipGetDevice(&dev);
        hipDeviceGetAttribute(&cus, hipDeviceAttributeMultiprocessorCount, dev);
        hipFuncSetAttribute((const void*)fwd_kernel, hipFuncAttributeMaxDynamicSharedMemorySize, LDS_BYTES);
        hipOccupancyMaxActiveBlocksPerMultiprocessor(&per_cu, (const void*)fwd_kernel, 512, LDS_BYTES);
        if (per_cu < 1) { fprintf(stderr, "kernel_launch: occupancy query says %d blocks per CU\n", per_cu); per_cu = 1; }
        (void)hipGetLastError();
        grid_blocks = cus;
    }
    if (grid_blocks < 0) return;
    Args a{};
    for (int i = 0; i < 28; ++i) a.in[i] = (const float*)d_in[i];
    a.out = (float*)d_out; a.ws = (unsigned char*)d_ws;
    void* args[] = {&a};
    hipError_t e = hipLaunchCooperativeKernel((const void*)fwd_kernel, dim3(grid_blocks), dim3(512), args, LDS_BYTES, stream);
    if (e != hipSuccess) fprintf(stderr, "cooperative launch failed: %s (grid %d)\n", hipGetErrorString(e), grid_blocks);
}
```

```cpp
#include <hip/hip_runtime.h>
#include <hip/hip_cooperative_groups.h>
#include <cstdio>
#include <cstdint>
namespace cg = cooperative_groups;
namespace pg8 {
#define PG8_LAS __attribute__((address_space(3)))
typedef unsigned short bf16_t;
typedef short bf16x8 __attribute__((ext_vector_type(8)));
typedef float f32x4 __attribute__((ext_vector_type(4)));
typedef unsigned u32x4 __attribute__((ext_vector_type(4)));
constexpr int BM = 256, BK = 64, HALF = 128, HTB = HALF * BK * 2  , STAGE_BYTES = 8 * HTB, NXCD = 8, WGM = 8;

__host__ __device__ __forceinline__ int lds_byte(int r, int c) { const int st = (r >> 4) * 2 + (c >> 5), rr = r & 15, cc = c & 31, ob = rr * 64 + cc * 2; return st * 1024 + (ob ^ (((ob >> 9) & 1) << 5)); }
__host__ __device__ __forceinline__ void stage_rc(int b, int& R, int& C) { const int st = b / 1024, sb = b % 1024, swz = sb ^ (((sb >> 9) & 1) << 5); R = (st >> 1) * 16 + swz / 64; C = (st & 1) * 32 + (swz % 64) / 2; }
__host__ __device__ __forceinline__ int perm32(int rho) { const int n = rho >> 4, i = rho & 15; return 8 * (i >> 2) + 4 * n + (i & 3); }

struct Unit { int pm, pn; };
struct Gemm { const bf16_t* A; const bf16_t* Bt; int M, N, K; };

struct StaticOrder {
    int nM, nN, nwg, G, c;
    __host__ __device__ void init(int M, int N, int G_, int c_) { nM = M / BM; nN = N / BM; nwg = nM * nN; G = G_; c = c_; }
    __host__ __device__ bool next(int i, Unit& u) const {
        const long L = (long)i * G + c; if (L >= nwg) return false;
        int wgid = (int)L; { const int q = nwg / NXCD, r = nwg % NXCD, xcd = wgid % NXCD, off = wgid / NXCD; wgid = (xcd < r ? xcd * (q + 1) : r * (q + 1) + (xcd - r) * q) + off; }
        const int nig = WGM * nN, gid = wgid / nig, fm = gid * WGM, gsz = (nM - fm) < WGM ? (nM - fm) : WGM;
        u.pm = fm + ((wgid % nig) % gsz); u.pn = (wgid % nig) / gsz; return true;
    }
    __device__ __forceinline__ void a_ready(const Unit&) const {}
    __device__ __forceinline__ void done(const Unit&) const {}
};
__device__ __forceinline__ unsigned cvt_pk_bf16(float lo, float hi) { unsigned r; asm volatile("v_cvt_pk_bf16_f32 %0, %1, %2" : "=v"(r) : "v"(lo), "v"(hi)); return r; }
__device__ __forceinline__ float bf_lo(unsigned w) { return __uint_as_float(w << 16); }
__device__ __forceinline__ float bf_hi(unsigned w) { return __uint_as_float(w & 0xffff0000u); }

__device__ __forceinline__ unsigned f2bf_rne(float f) { unsigned u = __float_as_uint(f); return (u + 0x7fffu + ((u >> 16) & 1u)) >> 16; }
struct EpiBf16 {
    static constexpr bool PERM = true, AFTER_DRAIN = false;
    bf16_t* O; int ldc; const float* bias;
    __device__ __forceinline__ void one(int row, int col, float v) const { O[(size_t)row * ldc + col] = (bf16_t)f2bf_rne(v + bias[col]); }
    __device__ __forceinline__ void operator()(const f32x4 (&acc)[2][2][4][2], const Unit& u, int wr, int wc, int fr, int fq) const {
        const int row0 = u.pm * BM + wr * 64 + fr; const int col0 = u.pn * BM + wc * 32 + 8 * fq;
        f32x4 bv[2][2];
#pragma unroll
        for (int bj = 0; bj < 2; ++bj)
#pragma unroll
            for (int n = 0; n < 2; ++n) bv[bj][n] = *(const f32x4*)(bias + col0 + bj * HALF + 4 * n);
#pragma unroll
        for (int ai = 0; ai < 2; ++ai)
#pragma unroll
            for (int m = 0; m < 4; ++m) { bf16_t* rowp = O + (size_t)(row0 + ai * HALF + m * 16) * ldc + col0;
#pragma unroll
                for (int bj = 0; bj < 2; ++bj) { const f32x4 v0 = acc[ai][bj][m][0] + bv[bj][0], v1 = acc[ai][bj][m][1] + bv[bj][1];
                    u32x4 w; w.x = cvt_pk_bf16(v0[0], v0[1]); w.y = cvt_pk_bf16(v0[2], v0[3]); w.z = cvt_pk_bf16(v1[0], v1[1]); w.w = cvt_pk_bf16(v1[2], v1[3]);
                    *(u32x4*)(rowp + bj * HALF) = w; } }
    }
};
template <bool BASE_F32> struct EpiRes {
    static constexpr bool PERM = false, AFTER_DRAIN = false;
    float* Y; const float* bias; const float* x; const float* meta; const bf16_t* xb; float alpha;
    __device__ __forceinline__ void one(int row, int col, float v) const {
        float bs;
        if (BASE_F32) bs = (row < 16384 ? x + (size_t)row * 1024 : meta + (size_t)((row - 16384) & 15) * 1024)[col];
        else bs = __uint_as_float(((unsigned)xb[(size_t)row * 1024 + col]) << 16);
        Y[(size_t)row * 1024 + col] = v + bias[col] + bs * alpha; }
    __device__ __forceinline__ void operator()(const f32x4 (&acc)[2][2][4][2], const Unit& u, int wr, int wc, int fr, int fq) const {
        const int row0 = u.pm * BM + wr * 64 + fr, col0 = u.pn * BM + wc * 32 + 4 * fq;
        f32x4 bv[2][2];
#pragma unroll
        for (int bj = 0; bj < 2; ++bj)
#pragma unroll
            for (int n = 0; n < 2; ++n) bv[bj][n] = *(const f32x4*)(bias + col0 + bj * HALF + n * 16);
#pragma unroll
        for (int ai = 0; ai < 2; ++ai)
#pragma unroll
            for (int m = 0; m < 4; ++m) { const int row = row0 + ai * HALF + m * 16; float* rowp = Y + (size_t)row * 1024 + col0;
                if (BASE_F32) { const float* bp = (row < 16384 ? x + (size_t)row * 1024 : meta + (size_t)((row - 16384) & 15) * 1024) + col0;
#pragma unroll
                    for (int bj = 0; bj < 2; ++bj)
#pragma unroll
                        for (int n = 0; n < 2; ++n) { const f32x4 b = *(const f32x4*)(bp + bj * HALF + n * 16); *(f32x4*)(rowp + bj * HALF + n * 16) = acc[ai][bj][m][n] + bv[bj][n] + b * alpha; }
                } else { const bf16_t* bp = xb + (size_t)row * 1024 + col0;
#pragma unroll
                    for (int bj = 0; bj < 2; ++bj)
#pragma unroll
                        for (int n = 0; n < 2; ++n) { const uint2 b = *(const uint2*)(bp + bj * HALF + n * 16); const f32x4 bf = (f32x4){bf_lo(b.x), bf_hi(b.x), bf_lo(b.y), bf_hi(b.y)};
                            *(f32x4*)(rowp + bj * HALF + n * 16) = acc[ai][bj][m][n] + bv[bj][n] + bf * alpha; } }
                asm volatile("" ::: "memory"); }
    }
};

template <class Epi, class Sched, bool STAMP = false>
__device__ __forceinline__ void gemm_phase(PG8_LAS unsigned char* lds, const Gemm g, const Sched& S, const Epi& E, unsigned long long* stamps) {
    int tid = threadIdx.x; asm volatile("" : "+v"(tid));
    const int wid = __builtin_amdgcn_readfirstlane(tid >> 6), lane = tid & 63, wr = wid >> 2, wc = wid & 3, fr = lane & 15, fq = lane >> 4;
    const int K = g.K, nt = K / BK;
    int ts_lo = 0, ts_hi = 0, nts = 0; const unsigned long long rt_entry = STAMP ? (unsigned long long)wall_clock64() : 0ull;
#define PG8_STAMP() do { if (STAMP && wid == 0 && nts < 64) { const unsigned long long _c = (unsigned long long)clock64(); \
        ts_lo = (lane == nts) ? (int)(unsigned)_c : ts_lo; ts_hi = (lane == nts) ? (int)(unsigned)(_c >> 32) : ts_hi; ++nts; } } while (0)
    PG8_STAMP();
    unsigned voffA[2], voffB[2];
#pragma unroll
    for (int i = 0; i < 2; ++i) { int R, C; stage_rc(tid * 16 + i * 8192, R, C); const int Rb = Epi::PERM ? ((R & ~31) + perm32(R & 31)) : R;
        voffA[i] = (unsigned)(R * K + C) * 2u; voffB[i] = (unsigned)(Rb * K + C) * 2u; }
    const size_t kstep = (size_t)(BK * 2);
    const size_t hstep = (size_t)HALF * K * 2;
    const size_t tstep = 2 * hstep;
    const unsigned ldsw = (unsigned)wid * 1024u;
    const int aoff = lds_byte(wr * 64 + fr, fq * 8), boff = lds_byte(wc * 32 + fr, fq * 8);
#define PG8_SA(b, h) (((b) * 2 + (h)) * HTB)
#define PG8_SB(b, h) ((4 + (b) * 2 + (h)) * HTB)
#define PG8_STAGE(bufoff, gbase, voff) do { _Pragma("unroll") for (int _i = 0; _i < 2; ++_i) \
        __builtin_amdgcn_global_load_lds((const unsigned*)((const char*)(gbase) + (voff)[_i]), (PG8_LAS unsigned*)(lds + (bufoff) + ldsw + _i * 8192), 16, 0, 0); } while (0)
#define PG8_LDA(dst, b, h) do { _Pragma("unroll") for (int m = 0; m < 4; ++m) _Pragma("unroll") for (int k = 0; k < 2; ++k) dst[m][k] = *(const PG8_LAS bf16x8*)(lds + PG8_SA(b, h) + aoff + m * 2048 + k * 1024); } while (0)
#define PG8_LDB(dst, b, h) do { _Pragma("unroll") for (int n = 0; n < 2; ++n) _Pragma("unroll") for (int k = 0; k < 2; ++k) dst[n][k] = *(const PG8_LAS bf16x8*)(lds + PG8_SB(b, h) + boff + n * 2048 + k * 1024); } while (0)
#define PG8_MMA(ai, bj, At, Bt) do { __builtin_amdgcn_s_setprio(1); _Pragma("unroll") for (int m = 0; m < 4; ++m) _Pragma("unroll") for (int n = 0; n < 2; ++n) _Pragma("unroll") for (int k = 0; k < 2; ++k) \
        acc[ai][bj][m][n] = __builtin_amdgcn_mfma_f32_16x16x32_bf16(Bt[n][k], At[m][k], acc[ai][bj][m][n], 0, 0, 0); __builtin_amdgcn_s_setprio(0); } while (0)
#define PG8_WAIT_V(n) asm volatile("s_waitcnt vmcnt(" #n ")" ::: "memory")
#define PG8_WAIT_L(n) asm volatile("s_waitcnt lgkmcnt(" #n ")" ::: "memory")
#define PG8_BAR __builtin_amdgcn_s_barrier()
#define PG8_SCHED __builtin_amdgcn_sched_barrier(0)
    Unit cur, nxt; int ui = 0;
    if (!S.next(0, cur)) return;
    f32x4 acc[2][2][4][2];
#pragma unroll
    for (int a = 0; a < 2; ++a)
#pragma unroll
        for (int b = 0; b < 2; ++b)
#pragma unroll
            for (int m = 0; m < 4; ++m)
#pragma unroll
                for (int n = 0; n < 2; ++n) acc[a][b][m][n] = (f32x4){0.f, 0.f, 0.f, 0.f};
    bf16x8 At[4][2], B0[2][2], B1[2][2];
    const char* cA = (const char*)g.A + (size_t)cur.pm * tstep; const char* cB = (const char*)g.Bt + (size_t)cur.pn * tstep;
    S.a_ready(cur);
    PG8_STAGE(PG8_SB(0, 0), cB, voffB); PG8_STAGE(PG8_SA(0, 0), cA, voffA); PG8_STAGE(PG8_SB(0, 1), cB + hstep, voffB); PG8_STAGE(PG8_SA(0, 1), cA + hstep, voffA);
    if (wr == 1) PG8_BAR;
    PG8_WAIT_V(4); PG8_BAR;
    PG8_STAGE(PG8_SB(1, 0), cB + kstep, voffB); PG8_STAGE(PG8_SA(1, 0), cA + kstep, voffA); PG8_STAGE(PG8_SB(1, 1), cB + hstep + kstep, voffB);
    PG8_WAIT_V(6); PG8_BAR;
    PG8_STAMP();
    for (;;) {
        const bool has_next = S.next(ui + 1, nxt);
        const char* nA = has_next ? (const char*)g.A + (size_t)nxt.pm * tstep : cA; const char* nB = has_next ? (const char*)g.Bt + (size_t)nxt.pn * tstep : cB;
#pragma unroll 1
        for (int t = 0; t < nt; t += 2) {
            const bool last = (t == nt - 2);
            const char* a1 = cA + (size_t)(t + 1) * kstep;
            const char* a2 = last ? nA : cA + (size_t)(t + 2) * kstep; const char* b2 = last ? nB : cB + (size_t)(t + 2) * kstep;
            const char* a3 = a2 + kstep; const char* b3 = b2 + kstep;
            if (last && has_next) S.a_ready(nxt);
            PG8_LDB(B0, 0, 0); PG8_SCHED; PG8_LDA(At, 0, 0); PG8_STAGE(PG8_SA(1, 1), a1 + hstep, voffA);
            PG8_WAIT_L(8); PG8_BAR; PG8_WAIT_L(0); PG8_MMA(0, 0, At, B0); PG8_BAR; PG8_SCHED;
            PG8_LDB(B1, 0, 1); PG8_STAGE(PG8_SB(0, 0), b2, voffB);
            PG8_BAR; PG8_WAIT_L(0); PG8_MMA(0, 1, At, B1); PG8_BAR;
            PG8_LDA(At, 0, 1); PG8_STAGE(PG8_SA(0, 0), a2, voffA);
            PG8_BAR; PG8_WAIT_L(0); PG8_MMA(1, 0, At, B0); PG8_BAR; PG8_SCHED;
            PG8_STAGE(PG8_SB(0, 1), b2 + hstep, voffB);
            PG8_WAIT_V(6); PG8_BAR; PG8_MMA(1, 1, At, B1); PG8_BAR;
            PG8_LDB(B0, 1, 0); PG8_SCHED; PG8_LDA(At, 1, 0); PG8_STAGE(PG8_SA(0, 1), a2 + hstep, voffA);
            PG8_WAIT_L(8); PG8_BAR; PG8_WAIT_L(0); PG8_MMA(0, 0, At, B0); PG8_BAR; PG8_SCHED;
            PG8_LDB(B1, 1, 1); PG8_STAGE(PG8_SB(1, 0), b3, voffB);
            PG8_BAR; PG8_WAIT_L(0); PG8_MMA(0, 1, At, B1); PG8_BAR;
            PG8_LDA(At, 1, 1); PG8_STAGE(PG8_SA(1, 0), a3, voffA);
            PG8_BAR; PG8_WAIT_L(0); PG8_MMA(1, 0, At, B0); PG8_BAR; PG8_SCHED;
            PG8_STAGE(PG8_SB(1, 1), b3 + hstep, voffB);
            PG8_WAIT_V(6); PG8_BAR; PG8_MMA(1, 1, At, B1); PG8_BAR;
        }
        PG8_STAMP();
        if constexpr (!Epi::AFTER_DRAIN) { E(acc, cur, wr, wc, fr, fq); S.done(cur); }
        PG8_STAMP();
        if (!has_next) break;
#pragma unroll
        for (int a = 0; a < 2; ++a)
#pragma unroll
            for (int b = 0; b < 2; ++b)
#pragma unroll
                for (int m = 0; m < 4; ++m)
#pragma unroll
                    for (int n = 0; n < 2; ++n) acc[a][b][m][n] = (f32x4){0.f, 0.f, 0.f, 0.f};
        cur = nxt; cA = nA; cB = nB; ++ui;
    }
    PG8_WAIT_V(0);
    if (wr == 0) PG8_BAR;
    PG8_BAR;
    if constexpr (Epi::AFTER_DRAIN) { E.fused(acc, cur, wr, wc, fr, fq, lds, wid, lane); S.done(cur); }
    PG8_STAMP();
    if (STAMP && wid == 0) { stamps[lane] = lane < nts ? (((unsigned long long)(unsigned)ts_hi << 32) | (unsigned)ts_lo) : 0ull;
        if (lane == 62) stamps[62] = rt_entry; if (lane == 63) stamps[63] = (unsigned long long)wall_clock64(); }
#undef PG8_STAMP
#undef PG8_SA
#undef PG8_SB
#undef PG8_STAGE
#undef PG8_LDA
#undef PG8_LDB
#undef PG8_MMA
#undef PG8_WAIT_V
#undef PG8_WAIT_L
#undef PG8_BAR
#undef PG8_SCHED
}
}
#define LAS __attribute__((address_space(3)))
typedef pg8::bf16_t bf16_t;
typedef pg8::f32x4 f32x4;
constexpr int D = 1024, NB = 8, SEQ = 2048, NMETA = 16, LTOK = SEQ + NMETA;
constexpr int MMAIN = NB * SEQ, MMETA = NB * NMETA, MREAL = MMAIN + MMETA, MP = 16640;
constexpr int NINAB = 1536, NINC = 3072, DFF = 2816, NUP = 5632, HUP = 2816, HCH = 1408;
constexpr float ALPHA = 1.41421356237309515f, LN_EPS = 1e-5f;
constexpr size_t MiB = 1u << 20;
constexpr size_t WS_BUP = 0;
constexpr size_t WS_W_INAB = 1 * MiB, WS_W_OUTAB = 4 * MiB, WS_W_INC = 6 * MiB, WS_W_OUTC = 12 * MiB, WS_W_UP = 14 * MiB, WS_W_DN = 36 * MiB;
constexpr size_t SZ_W_UP = (size_t)NUP * D * 2, SZ_W_DN = (size_t)D * DFF * 2;
constexpr size_t WS_R1 = 48 * MiB, WS_R2 = 146 * MiB, WS_END = 236 * MiB;
static_assert(WS_W_DN + 2 * SZ_W_DN <= WS_R1 && WS_R1 + (size_t)MP * 3072 * 2 <= WS_R2 && WS_R2 + (size_t)MP * DFF * 2 <= WS_END, "ws map");
constexpr size_t WS_BAR = 65536;
constexpr int LDS_BYTES = 147456, LDS_BARW = LDS_BYTES - 64;

__device__ __forceinline__ int row_of(int b, int t) { return t < NMETA ? MMAIN + b * NMETA + t : b * SEQ + (t - NMETA); }
__device__ __forceinline__ float sigmoidf_(float x) { return 1.0f / (1.0f + __expf(-x)); }
__device__ __forceinline__ float siluf_(float x) { return x / (1.0f + __expf(-x)); }
__device__ __forceinline__ unsigned f2bf(float f) { unsigned u = __float_as_uint(f); return (u + 0x7fffu + ((u >> 16) & 1u)) >> 16; }
__device__ __forceinline__ unsigned pk2(float lo, float hi) { return f2bf(lo) | (f2bf(hi) << 16); }
__device__ __forceinline__ float bflo(unsigned w) { return __uint_as_float(w << 16); }
__device__ __forceinline__ float bfhi(unsigned w) { return __uint_as_float(w & 0xffff0000u); }
__device__ __forceinline__ float bf1(const bf16_t* p) { return __uint_as_float(((unsigned)*p) << 16); }
__device__ __forceinline__ float wave_sum(float v) {
#pragma unroll
    for (int o = 1; o < 64; o <<= 1) v += __shfl_xor(v, o);
    return v;
}
__device__ __forceinline__ int opaque_tid() { int t = threadIdx.x; asm volatile("" : "+v"(t)); return t; }
__device__ __forceinline__ int opaque_bid() { int t = blockIdx.x; asm volatile("" : "+s"(t)); return t; }
#define UNPACK8(v, f) do { f[0] = bflo(v.x); f[1] = bfhi(v.x); f[2] = bflo(v.y); f[3] = bfhi(v.y); f[4] = bflo(v.z); f[5] = bfhi(v.z); f[6] = bflo(v.w); f[7] = bfhi(v.w); } while (0)

struct Args { const float* in[28]; float* out; unsigned char* ws; };
enum { I_X = 0, I_META, I_W_IN_AB, I_B_IN_AB, I_CONV_A_W, I_CONV_A_B, I_NORM_A_G, I_NORM_A_B, I_POOL_W, I_POOL_SCALE, I_W_OUT_AB, I_B_OUT_AB, I_W_IN_C, I_B_IN_C, I_CONV_C_W, I_CONV_C_B,
       I_W_OUT_C, I_B_OUT_C, I_MIX_LN_G, I_MIX_LN_B, I_FFN_W_UP, I_FFN_B_UP, I_FFN_CONV_W, I_FFN_CONV_B, I_FFN_W_DOWN, I_FFN_B_DOWN, I_FFN_LN_G, I_FFN_LN_B };

#define XB_TMO      128
#define XB_XCNT(j)  (256  + 64 * (j))
#define XB_XSUB(j)  (1280 + 64 * (j))
#define XB_XGEN(j)  (2304 + 64 * (j))
#define XB_TOP      3328
#define XB_TOPGEN   3392
#define XCD_BAR_WORDS 3456
#define XB_SPIN_CAP (1u << 18)

__device__ __forceinline__ unsigned xb_ld(unsigned* p)              { return __hip_atomic_load(p, __ATOMIC_RELAXED, __HIP_MEMORY_SCOPE_AGENT); }
__device__ __forceinline__ unsigned xb_add(unsigned* p, unsigned v) { return __hip_atomic_fetch_add(p, v, __ATOMIC_RELAXED, __HIP_MEMORY_SCOPE_AGENT); }
__device__ __forceinline__ unsigned xb_xcc_id() { return (unsigned)__builtin_amdgcn_s_getreg((3 << 11) | 20) & 0xFu; }
#define XB_SPIN(cond, bar) do { unsigned _sp = 0; while (cond) { __builtin_amdgcn_s_sleep(1); \
    if ((++_sp & 255u) == 0u) { if (xb_ld(&(bar)[XB_TMO])) break; if (_sp > XB_SPIN_CAP) { atomicAdd(&(bar)[XB_TMO], 1u); break; } } } } while (0)

struct XcdBarrier {
    unsigned* bar; unsigned x;
    volatile LAS unsigned* st;
};

__device__ __forceinline__ XcdBarrier xcd_barrier_post(unsigned* bar, volatile LAS unsigned* st) {
    XcdBarrier b; b.bar = bar; b.x = xb_xcc_id(); b.st = st;
    if (threadIdx.x == 0) (void)xb_add(&bar[XB_XCNT(b.x)], 1u);
    return b;
}
__device__ __forceinline__ void xcd_barrier_complete(unsigned* bar, unsigned x, unsigned& nloc, unsigned& nx) {
    const unsigned G = gridDim.x * gridDim.y * gridDim.z;
    unsigned sum, cnt, mine, sp = 0u;
    for (;;) {
        sum = 0u; cnt = 0u; mine = 0u;
#pragma unroll
        for (unsigned j = 0; j < 16; ++j) { const unsigned c = xb_ld(&bar[XB_XCNT(j)]); sum += c; cnt += (c > 0u) ? 1u : 0u; mine = (j == x) ? c : mine; }
        if (sum == G) break;
        __builtin_amdgcn_s_sleep(1);
        if ((++sp & 255u) == 0u) { if (xb_ld(&bar[XB_TMO])) break; if (sp > XB_SPIN_CAP) { atomicAdd(&bar[XB_TMO], 1u); break; } }
    }
    nloc = mine > 0u ? mine : 1u; nx = cnt > 0u ? cnt : 1u;
}

__device__ __forceinline__ void xcd_barrier(const XcdBarrier& b) {
    asm volatile("s_waitcnt vmcnt(0)" ::: "memory");
    __syncthreads();
    if (threadIdx.x == 0) {
        unsigned* bar = b.bar;
        __builtin_amdgcn_s_waitcnt(0);
        unsigned nloc = b.st[0], nx = b.st[1];
        if (nloc == 0u) { xcd_barrier_complete(bar, b.x, nloc, nx); b.st[0] = nloc; b.st[1] = nx; }
        const unsigned old = xb_add(&bar[XB_XSUB(b.x)], 1u);
        const unsigned gen = old / nloc;
        if (old + 1u == (gen + 1u) * nloc) {
            __builtin_amdgcn_fence(__ATOMIC_RELEASE, "agent");
            asm volatile("s_waitcnt vmcnt(0)" ::: "memory");
            const unsigned og = xb_add(&bar[XB_TOP], 1u);
            const unsigned tg = og / nx;
            if (og + 1u == (tg + 1u) * nx) xb_add(&bar[XB_TOPGEN], 1u);
            else XB_SPIN(xb_ld(&bar[XB_TOPGEN]) == tg, bar);
            __builtin_amdgcn_fence(__ATOMIC_ACQUIRE, "agent");
            xb_add(&bar[XB_XGEN(b.x)], 1u);
            asm volatile("s_waitcnt vmcnt(0)" ::: "memory");
        } else {
            XB_SPIN(xb_ld(&bar[XB_XGEN(b.x)]) == gen, bar);
            __builtin_amdgcn_fence(__ATOMIC_ACQUIRE, "agent");
            asm volatile("s_waitcnt vmcnt(0)" ::: "memory");
        }
    }
    __syncthreads();
}


template <int NKS, class Epi> __device__ __forceinline__ void skinny_gemm(LAS unsigned char* lds, const bf16_t* A, const bf16_t* Bt, int N, const Epi& E) {
    typedef pg8::bf16x8 bf16x8;
    constexpr int K = NKS * 256;
    const int tid = opaque_tid(), lane = tid & 63, wave = tid >> 6, fr = lane & 15, fq = lane >> 4, G = gridDim.x, c = G - 1 - opaque_bid();
    const int nitems = 4 * (N >> 4);
    LAS f32x4* red = (LAS f32x4*)lds;
    for (int item = c; item < nitems; item += G) {
        const int rb = item & 3, cgp = item >> 2;
        const bf16_t* ap = A + (size_t)(MMAIN + 32 * rb + fr) * K + wave * (K / 8) + 8 * fq;
        const bf16_t* bp = Bt + (size_t)(16 * cgp + fr) * K + wave * (K / 8) + 8 * fq;
        bf16x8 a0[NKS], a1[NKS], bb[NKS];
#pragma unroll
        for (int s = 0; s < NKS; ++s) { a0[s] = *(const bf16x8*)(ap + 32 * s); a1[s] = *(const bf16x8*)(ap + (size_t)16 * K + 32 * s); bb[s] = *(const bf16x8*)(bp + 32 * s); }
        f32x4 acc0 = (f32x4){0.f, 0.f, 0.f, 0.f}, acc1 = acc0;
#pragma unroll
        for (int s = 0; s < NKS; ++s) { acc0 = __builtin_amdgcn_mfma_f32_16x16x32_bf16(bb[s], a0[s], acc0, 0, 0, 0); acc1 = __builtin_amdgcn_mfma_f32_16x16x32_bf16(bb[s], a1[s], acc1, 0, 0, 0); }
        __syncthreads();
        red[(wave * 2 + 0) * 64 + lane] = acc0; red[(wave * 2 + 1) * 64 + lane] = acc1;
        __syncthreads();
        { const int p = tid >> 2, e = tid & 3; const LAS float* rf = (const LAS float*)lds; float s = 0.f;
#pragma unroll
          for (int w = 0; w < 8; ++w) s += rf[((w * 2 + (p >> 6)) * 64 + (p & 63)) * 4 + e];
          const int pl = p & 63; E.one(MMAIN + 32 * rb + 16 * (p >> 6) + (pl & 15), 16 * cgp + 4 * (pl >> 4) + e, s); }
    }
    __syncthreads();
}

__device__ __forceinline__ void transpose_item(const float* W, int ldw, int k0, int n0, bf16_t* dst, int ldo, LAS float* scr, int lane) {
#pragma unroll 8
    for (int i = 0; i < 32; ++i) { const int kk = 2 * i + (lane >> 5); scr[kk * 33 + (lane & 31)] = W[(size_t)(k0 + kk) * ldw + n0 + (lane & 31)]; }
    asm volatile("s_waitcnt lgkmcnt(0)" ::: "memory");
    const int c = lane & 7;
#pragma unroll
    for (int j = 0; j < 4; ++j) { const int n = (lane >> 3) + 8 * j; const LAS float* s = scr + (8 * c) * 33 + n;
        uint4 o; o.x = pk2(s[0 * 33], s[1 * 33]); o.y = pk2(s[2 * 33], s[3 * 33]); o.z = pk2(s[4 * 33], s[5 * 33]); o.w = pk2(s[6 * 33], s[7 * 33]);
        *(uint4*)(dst + (size_t)n * ldo + 8 * c) = o; }
    asm volatile("s_waitcnt lgkmcnt(0)" ::: "memory");
}
__device__ __forceinline__ void phase_prep(const Args& a, LAS unsigned char* lds) {
    const int tid = opaque_tid(), lane = tid & 63, wave = tid >> 6, bid = opaque_bid();
    const int gw = bid * 8 + wave, NGW = gridDim.x * 8;
    unsigned char* ws = a.ws;
    LAS float* scr = (LAS float*)(lds + wave * 16384);
    bf16_t* W_INAB = (bf16_t*)(ws + WS_W_INAB); bf16_t* W_OUTAB = (bf16_t*)(ws + WS_W_OUTAB); bf16_t* W_INC = (bf16_t*)(ws + WS_W_INC); bf16_t* W_OUTC = (bf16_t*)(ws + WS_W_OUTC);
    constexpr int N1 = 16 * 48, N2 = 8 * 32, N3 = 16 * 96, N4 = 16 * 32, N5 = 16 * 176, N6 = 44 * 32;
    constexpr int NITEMS = N1 + N2 + N3 + N4 + 2 * N5 + 2 * N6;
    for (int it = gw; it < NITEMS; it += NGW) {
        int r = it;
        if (r < N1) { const int kb = r / 48, nb = r % 48; transpose_item(a.in[I_W_IN_AB], NINAB, 64 * kb, 32 * nb, W_INAB + (size_t)(32 * nb) * D + 64 * kb, D, scr, lane); continue; } r -= N1;
        if (r < N2) { const int kb = r / 32, nb = r % 32; transpose_item(a.in[I_W_OUT_AB], D, 64 * kb, 32 * nb, W_OUTAB + (size_t)(32 * nb) * D + 64 * kb, D, scr, lane); continue; } r -= N2;
        if (r < N3) { const int kb = r / 96, nb = r % 96; transpose_item(a.in[I_W_IN_C], NINC, 64 * kb, 32 * nb, W_INC + (size_t)(32 * nb) * D + 64 * kb, D, scr, lane); continue; } r -= N3;
        if (r < N4) { const int kb = r / 32, nb = r % 32; transpose_item(a.in[I_W_OUT_C], D, 64 * kb, 32 * nb, W_OUTC + (size_t)(32 * nb) * D + 64 * kb, D, scr, lane); continue; } r -= N4;
        if (r < 2 * N5) { const int l = r / N5; r -= l * N5; const int kb = r / 176, nb = r % 176; const int n0 = 32 * nb;
            const int ch = n0 < DFF ? n0 : n0 - DFF; const int orow = 256 * (ch >> 7) + (n0 < DFF ? 0 : 128) + (ch & 127);
            transpose_item(a.in[I_FFN_W_UP] + (size_t)l * D * NUP, NUP, 64 * kb, n0, (bf16_t*)(ws + WS_W_UP + l * SZ_W_UP) + (size_t)orow * D + 64 * kb, D, scr, lane); continue; } r -= 2 * N5;
        { const int l = r / N6; r -= l * N6; const int kb = r / 32, nb = r % 32;
            transpose_item(a.in[I_FFN_W_DOWN] + (size_t)l * DFF * D, D, 64 * kb, 32 * nb, (bf16_t*)(ws + WS_W_DN + l * SZ_W_DN) + (size_t)(32 * nb) * DFF + 64 * kb, DFF, scr, lane); }
    }
    { const float* pw = a.in[I_POOL_W]; const float* ps = a.in[I_POOL_SCALE]; const float* wo = a.in[I_W_OUT_AB];
      for (int idx = bid * 512 + tid; idx < 1024 * 512; idx += gridDim.x * 512) { const int kq = idx & 511, n = idx >> 9, g = kq >> 7;
          const float* pr = pw + (size_t)kq * 128; float s = 0.f;
#pragma unroll 8
          for (int d = 0; d < 128; ++d) s += pr[d] * (ps[g * 128 + d] * wo[(size_t)(512 + g * 128 + d) * D + n]);
          W_OUTAB[(size_t)n * D + 512 + kq] = (bf16_t)f2bf(s); } }
    { float* bup = (float*)(ws + WS_BUP);
      for (int idx = bid * 512 + tid; idx < 2 * NUP; idx += gridDim.x * 512) { const int l = idx / NUP, c = idx % NUP, j = c >> 8, bj = (c >> 7) & 1, i = c & 127;
          bup[idx] = a.in[I_FFN_B_UP][l * NUP + (bj ? DFF : 0) + 128 * j + i]; } }
    { bf16_t* XB = (bf16_t*)a.out;
      for (int m = gw; m < MP; m += NGW) { uint2* o8 = (uint2*)(XB + (size_t)m * D) + lane;
          if (m < MREAL) { const float* src = m < MMAIN ? a.in[I_X] + (size_t)m * D : a.in[I_META] + (size_t)((m - MMAIN) & 15) * D; const f32x4* xr = (const f32x4*)src + lane;
#pragma unroll
              for (int j = 0; j < 4; ++j) { const f32x4 v = xr[64 * j]; o8[64 * j] = make_uint2(pk2(v.x, v.y), pk2(v.z, v.w)); } }
          else {
#pragma unroll
              for (int j = 0; j < 4; ++j) o8[64 * j] = make_uint2(0u, 0u); } } }
}

__device__ __forceinline__ void phase_mixer0(const Args& a, LAS unsigned char* lds, const bf16_t* Hab, bf16_t* AP) {
    constexpr int T = 34, NT = 61;
    const int tid = opaque_tid(), lane = tid & 63, wave = tid >> 6, bid = opaque_bid();
    LAS float* la = (LAS float*)lds;
    LAS float* part = (LAS float*)(lds + 131072);
    LAS float* stat = (LAS float*)(lds + 131072 + 2304);
    float w[31];
#pragma unroll
    for (int j = 0; j < 31; ++j) w[j] = a.in[I_CONV_A_W][j * 512 + tid];
    const float cb = a.in[I_CONV_A_B][tid], ng = a.in[I_NORM_A_G][tid], nbb = a.in[I_NORM_A_B][tid];
    for (int item = bid; item < NB * NT; item += gridDim.x) {
        const int b = item / NT, t0 = (item % NT) * T;
        __syncthreads();
#pragma unroll
        for (int i = 0; i < 8; ++i) { const int q = tid + 512 * i, j = q >> 6, c8 = q & 63, pos = t0 - 15 + j;
            float av[8];
#pragma unroll
            for (int e = 0; e < 8; ++e) av[e] = 0.f;
            if (pos >= 0 && pos < LTOK) { const bf16_t* rp = Hab + (size_t)row_of(b, pos) * NINAB + 8 * c8; const uint4 vv = *(const uint4*)rp, gg = *(const uint4*)(rp + 512);
                float fv[8], fg[8]; UNPACK8(vv, fv); UNPACK8(gg, fg);
#pragma unroll
                for (int e = 0; e < 8; ++e) av[e] = fv[e] * sigmoidf_(fg[e]); }
            LAS f32x4* dst = (LAS f32x4*)(la + j * 512 + 8 * c8); dst[0] = (f32x4){av[0], av[1], av[2], av[3]}; dst[1] = (f32x4){av[4], av[5], av[6], av[7]}; }
        __syncthreads();
        float o[T];
#pragma unroll
        for (int p = 0; p < T; ++p) { float acc = cb;
#pragma unroll
            for (int j = 0; j < 31; ++j) acc += w[j] * la[(p + j) * 512 + tid];
            o[p] = acc; }
#pragma unroll
        for (int p = 0; p < T; ++p) { const float s1 = wave_sum(o[p]), s2 = wave_sum(o[p] * o[p]); if (lane == 0) { part[(p * 8 + wave) * 2] = s1; part[(p * 8 + wave) * 2 + 1] = s2; } }
        __syncthreads();
        if (tid < T) { float s1 = 0.f, s2 = 0.f;
#pragma unroll
            for (int k = 0; k < 8; ++k) { s1 += part[(tid * 8 + k) * 2]; s2 += part[(tid * 8 + k) * 2 + 1]; }
            const float mean = s1 * (1.f / 512.f); float var = s2 * (1.f / 512.f) - mean * mean; var = var > 0.f ? var : 0.f;
            stat[2 * tid] = mean; stat[2 * tid + 1] = 1.0f / sqrtf(var + LN_EPS); }
        __syncthreads();
#pragma unroll
        for (int p = 0; p < T; ++p) { const int t = t0 + p;
            if (t < LTOK) { const float y = (o[p] - stat[2 * p]) * stat[2 * p + 1] * ng + nbb; AP[(size_t)row_of(b, t) * D + tid] = (bf16_t)f2bf(siluf_(y)); } }
        { const int half = 1 << (tid >> 7); const bf16_t* U = Hab + 1024 + tid;
          const int tend = (t0 + T < LTOK) ? t0 + T : LTOK;
          int lo = t0 - half; lo = lo < 0 ? 0 : lo; int hi = t0 + half; hi = hi > LTOK ? LTOK : hi;
          float s = 0.f;
          for (int q = lo; q < hi; ++q) s += bf1(U + (size_t)row_of(b, q) * NINAB);
          for (int t = t0; t < tend; ++t) {
              int l2 = t - half; l2 = l2 < 0 ? 0 : l2; int h2 = t + half; h2 = h2 > LTOK ? LTOK : h2;
              const float ut = bf1(U + (size_t)row_of(b, t) * NINAB);
              AP[(size_t)row_of(b, t) * D + 512 + tid] = (bf16_t)f2bf(s / (float)(h2 - l2) - ut);
              if (t + half < LTOK) s += bf1(U + (size_t)row_of(b, t + half) * NINAB);
              if (t - half >= 0) s -= bf1(U + (size_t)row_of(b, t - half) * NINAB);
          } }
    }
}

__device__ __forceinline__ void phase_act(const Args& a, const bf16_t* U, bf16_t* ACT, int l, int h) {
    const float* cw = a.in[I_FFN_CONV_W] + (size_t)l * 3 * DFF; const float* cbp = a.in[I_FFN_CONV_B] + (size_t)l * DFF;
    const int nth = gridDim.x * 512;
    for (int idx = opaque_bid() * 512 + opaque_tid(); idx < MREAL * 176; idx += nth) {
        const int r = idx / 176, q = idx - r * 176, b = r / LTOK, t = r - b * LTOK;
        const int jt = q >> 4, i8 = (q & 15) * 8, gcol = 256 * jt + i8, ch = HCH * h + 128 * jt + i8;
        const int row = row_of(b, t);
        const bf16_t* up = U + (size_t)row * HUP + gcol;
        const uint4 g0v = *(const uint4*)up, vv = *(const uint4*)(up + 128);
        uint4 gmv = make_uint4(0, 0, 0, 0), gpv = make_uint4(0, 0, 0, 0);
        if (t > 0) gmv = *(const uint4*)(U + (size_t)row_of(b, t - 1) * HUP + gcol);
        if (t < LTOK - 1) gpv = *(const uint4*)(U + (size_t)row_of(b, t + 1) * HUP + gcol);
        float g0[8], gm[8], gp[8], v[8]; UNPACK8(g0v, g0); UNPACK8(gmv, gm); UNPACK8(gpv, gp); UNPACK8(vv, v);
        float w0[8], w1[8], w2[8], cb[8];
        *(f32x4*)&w0[0] = *(const f32x4*)(cw + ch); *(f32x4*)&w0[4] = *(const f32x4*)(cw + ch + 4);
        *(f32x4*)&w1[0] = *(const f32x4*)(cw + DFF + ch); *(f32x4*)&w1[4] = *(const f32x4*)(cw + DFF + ch + 4);
        *(f32x4*)&w2[0] = *(const f32x4*)(cw + 2 * DFF + ch); *(f32x4*)&w2[4] = *(const f32x4*)(cw + 2 * DFF + ch + 4);
        *(f32x4*)&cb[0] = *(const f32x4*)(cbp + ch); *(f32x4*)&cb[4] = *(const f32x4*)(cbp + ch + 4);
        float o[8];
#pragma unroll
        for (int e = 0; e < 8; ++e) o[e] = siluf_(w0[e] * gm[e] + w1[e] * g0[e] + w2[e] * gp[e] + cb[e]) * v[e];
        uint4 ov; ov.x = pk2(o[0], o[1]); ov.y = pk2(o[2], o[3]); ov.z = pk2(o[4], o[5]); ov.w = pk2(o[6], o[7]);
        *(uint4*)(ACT + (size_t)row * DFF + ch) = ov;
    }
}

__device__ __forceinline__ void phase_yc(const Args& a, const bf16_t* Hc, bf16_t* YC) {
    const float* cw = a.in[I_CONV_C_W]; const float* cbp = a.in[I_CONV_C_B];
    const int nth = gridDim.x * 512;
    for (int idx = opaque_bid() * 512 + opaque_tid(); idx < MREAL * 128; idx += nth) {
        const int r = idx >> 7, c8 = (idx & 127) * 8, b = r / LTOK, t = r - b * LTOK;
        const int row = row_of(b, t);
        const bf16_t* hp = Hc + (size_t)row * NINC + c8;
        const uint4 bgv = *(const uint4*)hp, c0v = *(const uint4*)(hp + 1024), v0v = *(const uint4*)(hp + 2048);
        uint4 cmv = make_uint4(0, 0, 0, 0), vmv = cmv, cpv = cmv, vpv = cmv;
        if (t > 0) { const bf16_t* p = Hc + (size_t)row_of(b, t - 1) * NINC + c8; cmv = *(const uint4*)(p + 1024); vmv = *(const uint4*)(p + 2048); }
        if (t < LTOK - 1) { const bf16_t* p = Hc + (size_t)row_of(b, t + 1) * NINC + c8; cpv = *(const uint4*)(p + 1024); vpv = *(const uint4*)(p + 2048); }
        float bg[8], c0[8], v0[8], cm[8], vm[8], cp[8], vp[8];
        UNPACK8(bgv, bg); UNPACK8(c0v, c0); UNPACK8(v0v, v0); UNPACK8(cmv, cm); UNPACK8(vmv, vm); UNPACK8(cpv, cp); UNPACK8(vpv, vp);
        float w0[8], w1[8], w2[8], cb[8];
        *(f32x4*)&w0[0] = *(const f32x4*)(cw + c8); *(f32x4*)&w0[4] = *(const f32x4*)(cw + c8 + 4);
        *(f32x4*)&w1[0] = *(const f32x4*)(cw + D + c8); *(f32x4*)&w1[4] = *(const f32x4*)(cw + D + c8 + 4);
        *(f32x4*)&w2[0] = *(const f32x4*)(cw + 2 * D + c8); *(f32x4*)&w2[4] = *(const f32x4*)(cw + 2 * D + c8 + 4);
        *(f32x4*)&cb[0] = *(const f32x4*)(cbp + c8); *(f32x4*)&cb[4] = *(const f32x4*)(cbp + c8 + 4);
        float o[8];
#pragma unroll
        for (int e = 0; e < 8; ++e) o[e] = bg[e] * (w0[e] * (cm[e] * vm[e]) + w1[e] * (c0[e] * v0[e]) + w2[e] * (cp[e] * vp[e]) + cb[e]);
        uint4 ov; ov.x = pk2(o[0], o[1]); ov.y = pk2(o[2], o[3]); ov.z = pk2(o[4], o[5]); ov.w = pk2(o[6], o[7]);
        *(uint4*)(YC + (size_t)row * D + c8) = ov;
    }
}

template <bool FINAL> __device__ __forceinline__ void phase_ln(const float* Y, const float* g, const float* bta, bf16_t* XB, float* out) {
    const int tid = opaque_tid(), lane = tid & 63, wave = tid >> 6, gw = opaque_bid() * 8 + wave, NGW = gridDim.x * 8;
    asm volatile("" ::: "memory");
    const int nrows = FINAL ? MMAIN : MREAL;
    for (int m = gw; m < nrows; m += NGW) {
        const f32x4* yr = (const f32x4*)(Y + (size_t)m * D) + lane;
        f32x4 v[4]; float s = 0.f;
#pragma unroll
        for (int j = 0; j < 4; ++j) { v[j] = yr[64 * j]; s += (v[j].x + v[j].y) + (v[j].z + v[j].w); }
        const float mean = wave_sum(s) * (1.f / D); float s2 = 0.f;
#pragma unroll
        for (int j = 0; j < 4; ++j) { v[j] = v[j] - mean; s2 += (v[j].x * v[j].x + v[j].y * v[j].y) + (v[j].z * v[j].z + v[j].w * v[j].w); }
        const float rstd = 1.f / sqrtf(wave_sum(s2) * (1.f / D) + LN_EPS);
        if (FINAL) { f32x4* o = (f32x4*)(out + (size_t)m * D) + lane;
#pragma unroll
            for (int j = 0; j < 4; ++j) o[64 * j] = v[j] * rstd * ((const f32x4*)g)[lane + 64 * j] + ((const f32x4*)bta)[lane + 64 * j]; }
        else { uint2* o8 = (uint2*)(XB + (size_t)m * D) + lane;
#pragma unroll
            for (int j = 0; j < 4; ++j) { const f32x4 y = v[j] * rstd * ((const f32x4*)g)[lane + 64 * j] + ((const f32x4*)bta)[lane + 64 * j]; o8[64 * j] = make_uint2(pk2(y.x, y.y), pk2(y.z, y.w)); } }
    }
}

template <int NKS, class Epi> __device__ __forceinline__ void run_gemm(LAS unsigned char* lds, const bf16_t* A, const bf16_t* Bt, int N, int K, const Epi& E) {
    asm volatile("" : "+s"(N), "+s"(K));
    pg8::Gemm g{A, Bt, MMAIN, N, K}; pg8::StaticOrder S; S.init(MMAIN, N, (int)gridDim.x, opaque_bid());
    pg8::gemm_phase<Epi, pg8::StaticOrder, false>(lds, g, S, E, nullptr);
    skinny_gemm<NKS>(lds, A, Bt, N, E);
}

#ifndef NREP
#define NREP 1
#endif
#ifndef NXSYNC
#define NXSYNC 0
#endif
__global__ void __launch_bounds__(512, 2) fwd_kernel(Args a) {
    extern __shared__ __attribute__((aligned(16))) unsigned char lds_raw[];
    LAS unsigned char* lds = (LAS unsigned char*)lds_raw;
    cg::grid_group grid = cg::this_grid();
    unsigned char* ws = a.ws;
    if (ws == nullptr) grid.sync();
    if (threadIdx.x < 16) ((LAS unsigned*)(lds + LDS_BARW))[threadIdx.x] = 0u;
    __syncthreads();
    const XcdBarrier bar = xcd_barrier_post((unsigned*)(ws + WS_BAR), (volatile LAS unsigned*)(lds + LDS_BARW));
#define GRID_SYNC() xcd_barrier(bar)
    bf16_t* XB = (bf16_t*)a.out;
    bf16_t* R1b = (bf16_t*)(ws + WS_R1); float* Y = (float*)(ws + WS_R1); bf16_t* R2b = (bf16_t*)(ws + WS_R2);
    const float* bup = (const float*)(ws + WS_BUP);

#ifndef SKIP_PREP
    for (int rep = 0; rep < NREP; ++rep) phase_prep(a, lds);
    for (int rep = 0; rep < NXSYNC; ++rep) GRID_SYNC();
#endif
    GRID_SYNC();
    { pg8::EpiBf16 E{R1b, NINAB, a.in[I_B_IN_AB]}; run_gemm<4>(lds, XB, (const bf16_t*)(ws + WS_W_INAB), NINAB, D, E); }
    GRID_SYNC();
#ifndef SKIP_MIX
    for (int rep = 0; rep < NREP; ++rep) phase_mixer0(a, lds, R1b, R2b);
#endif
    GRID_SYNC();
    { pg8::EpiRes<true> E{Y, a.in[I_B_OUT_AB], a.in[I_X], a.in[I_META], XB, ALPHA}; run_gemm<4>(lds, R2b, (const bf16_t*)(ws + WS_W_OUTAB), D, D, E); }
    GRID_SYNC();
#ifndef SKIP_LN
    for (int rep = 0; rep < NREP; ++rep) phase_ln<false>(Y, a.in[I_MIX_LN_G], a.in[I_MIX_LN_B], XB, nullptr);
#endif
    GRID_SYNC();
#pragma unroll 1
    for (int l = 0; l < 2; ++l) {
        if (l == 1) {
            { pg8::EpiBf16 E{R1b, NINC, a.in[I_B_IN_C]}; run_gemm<4>(lds, XB, (const bf16_t*)(ws + WS_W_INC), NINC, D, E); }
            GRID_SYNC();
#ifndef SKIP_YC
            for (int rep = 0; rep < NREP; ++rep) phase_yc(a, R1b, R2b);
#endif
            GRID_SYNC();
            { pg8::EpiRes<false> E{Y, a.in[I_B_OUT_C], nullptr, nullptr, XB, ALPHA}; run_gemm<4>(lds, R2b, (const bf16_t*)(ws + WS_W_OUTC), D, D, E); }
            GRID_SYNC();
#ifndef SKIP_LN
            for (int rep = 0; rep < NREP; ++rep) phase_ln<false>(Y, a.in[I_MIX_LN_G] + D, a.in[I_MIX_LN_B] + D, XB, nullptr);
#endif
            GRID_SYNC();
        }
#pragma unroll 1
        for (int h = 0; h < 2; ++h) {
            { pg8::EpiBf16 E{R1b, HUP, bup + l * NUP + h * HUP}; run_gemm<4>(lds, XB, (const bf16_t*)(ws + WS_W_UP + l * SZ_W_UP) + (size_t)h * HUP * D, HUP, D, E); }
            GRID_SYNC();
#ifndef SKIP_ACT
            for (int rep = 0; rep < NREP; ++rep) phase_act(a, R1b, R2b, l, h);
#endif
            GRID_SYNC();
        }
        { pg8::EpiRes<false> E{Y, a.in[I_FFN_B_DOWN] + l * D, nullptr, nullptr, XB, ALPHA}; run_gemm<11>(lds, R2b, (const bf16_t*)(ws + WS_W_DN + l * SZ_W_DN), D, DFF, E); }
        GRID_SYNC();
#ifndef SKIP_LN
        if (l == 0) { for (int rep = 0; rep < NREP; ++rep) phase_ln<false>(Y, a.in[I_FFN_LN_G], a.in[I_FFN_LN_B], XB, nullptr); GRID_SYNC(); }
        else for (int rep = 0; rep < NREP; ++rep) phase_ln<true>(Y, a.in[I_FFN_LN_G] + D, a.in[I_FFN_LN_B] + D, nullptr, a.out);
#endif
    }
}

extern "C" void kernel_launch(void* const* d_in, const int* in_sizes, int n_in, void* d_out, int out_size, void* d_ws, size_t ws_size, hipStream_t stream) {
    static int grid_blocks = 0;
    if (!grid_blocks) {
        if (n_in != 28 || out_size != MMAIN * D || ws_size < WS_END) { fprintf(stderr, "kernel_launch: unexpected shapes: n_in %d out %d ws %zu\n", n_in, out_size, ws_size); grid_blocks = -1; return; }
        int dev = 0, cus = 0, per_cu = 0;
        hipGetDevice(&dev);
        hipDeviceGetAttribute(&cus, hipDeviceAttributeMultiprocessorCount, dev);
        hipFuncSetAttribute((const void*)fwd_kernel, hipFuncAttributeMaxDynamicSharedMemorySize, LDS_BYTES);
        hipOccupancyMaxActiveBlocksPerMultiprocessor(&per_cu, (const void*)fwd_kernel, 512, LDS_BYTES);
        if (per_cu < 1) { fprintf(stderr, "kernel_launch: occupancy query says %d blocks per CU\n", per_cu); per_cu = 1; }
        (void)hipGetLastError();
        grid_blocks = cus;
    }
    if (grid_blocks < 0) return;
    Args a{};
    for (int i = 0; i < 28; ++i) a.in[i] = (const float*)d_in[i];
    a.out = (float*)d_out; a.ws = (unsigned char*)d_ws;
    (void)hipMemsetAsync((unsigned char*)d_ws + WS_BAR, 0, 16384, stream);
    void* args[] = {&a};
    hipError_t e = hipLaunchCooperativeKernel((const void*)fwd_kernel, dim3(grid_blocks), dim3(512), args, LDS_BYTES, stream);
    if (e != hipSuccess) fprintf(stderr, "cooperative launch failed: %s (grid %d)\n", hipGetErrorString(e), grid_blocks);
}
```

```cpp
#include <hip/hip_runtime.h>
#include <hip/hip_cooperative_groups.h>
#include <cstdio>
#include <cstdint>
namespace cg = cooperative_groups;
namespace pg8 {
#define PG8_LAS __attribute__((address_space(3)))
typedef unsigned short bf16_t;
typedef short bf16x8 __attribute__((ext_vector_type(8)));
typedef float f32x4 __attribute__((ext_vector_type(4)));
typedef unsigned u32x4 __attribute__((ext_vector_type(4)));
constexpr int BM = 256, BK = 64, HALF = 128, HTB = HALF * BK * 2  , STAGE_BYTES = 8 * HTB, NXCD = 8, WGM = 8;

__host__ __device__ __forceinline__ int lds_byte(int r, int c) { const int st = (r >> 4) * 2 + (c >> 5), rr = r & 15, cc = c & 31, ob = rr * 64 + cc * 2; return st * 1024 + (ob ^ (((ob >> 9) & 1) << 5)); }
__host__ __device__ __forceinline__ void stage_rc(int b, int& R, int& C) { const int st = b / 1024, sb = b % 1024, swz = sb ^ (((sb >> 9) & 1) << 5); R = (st >> 1) * 16 + swz / 64; C = (st & 1) * 32 + (swz % 64) / 2; }
__host__ __device__ __forceinline__ int perm32(int rho) { const int n = rho >> 4, i = rho & 15; return 8 * (i >> 2) + 4 * n + (i & 3); }

struct Unit { int pm, pn; };
struct Gemm { const bf16_t* A; const bf16_t* Bt; int M, N, K; };

struct StaticOrder {
    int nM, nN, nwg, G, c;
    __host__ __device__ void init(int M, int N, int G_, int c_) { nM = M / BM; nN = N / BM; nwg = nM * nN; G = G_; c = c_; }
    __host__ __device__ bool next(int i, Unit& u) const {
        const long L = (long)i * G + c; if (L >= nwg) return false;
        int wgid = (int)L; { const int q = nwg / NXCD, r = nwg % NXCD, xcd = wgid % NXCD, off = wgid / NXCD; wgid = (xcd < r ? xcd * (q + 1) : r * (q + 1) + (xcd - r) * q) + off; }
        const int nig = WGM * nN, gid = wgid / nig, fm = gid * WGM, gsz = (nM - fm) < WGM ? (nM - fm) : WGM;
        u.pm = fm + ((wgid % nig) % gsz); u.pn = (wgid % nig) / gsz; return true;
    }
    __device__ __forceinline__ void a_ready(const Unit&) const {}
    __device__ __forceinline__ void done(const Unit&) const {}
};
__device__ __forceinline__ unsigned cvt_pk_bf16(float lo, float hi) { unsigned r; asm volatile("v_cvt_pk_bf16_f32 %0, %1, %2" : "=v"(r) : "v"(lo), "v"(hi)); return r; }
__device__ __forceinline__ float bf_lo(unsigned w) { return __uint_as_float(w << 16); }
__device__ __forceinline__ float bf_hi(unsigned w) { return __uint_as_float(w & 0xffff0000u); }

__device__ __forceinline__ unsigned f2bf_rne(float f) { unsigned u = __float_as_uint(f); return (u + 0x7fffu + ((u >> 16) & 1u)) >> 16; }
struct EpiBf16 {
    static constexpr bool PERM = true, AFTER_DRAIN = false;
    bf16_t* O; int ldc; const float* bias;
    __device__ __forceinline__ void one(int row, int col, float v) const { O[(size_t)row * ldc + col] = (bf16_t)f2bf_rne(v + bias[col]); }
    __device__ __forceinline__ void operator()(const f32x4 (&acc)[2][2][4][2], const Unit& u, int wr, int wc, int fr, int fq) const {
        const int row0 = u.pm * BM + wr * 64 + fr; const int col0 = u.pn * BM + wc * 32 + 8 * fq;
        f32x4 bv[2][2];
#pragma unroll
        for (int bj = 0; bj < 2; ++bj)
#pragma unroll
            for (int n = 0; n < 2; ++n) bv[bj][n] = *(const f32x4*)(bias + col0 + bj * HALF + 4 * n);
#pragma unroll
        for (int ai = 0; ai < 2; ++ai)
#pragma unroll
            for (int m = 0; m < 4; ++m) { bf16_t* rowp = O + (size_t)(row0 + ai * HALF + m * 16) * ldc + col0;
#pragma unroll
                for (int bj = 0; bj < 2; ++bj) { const f32x4 v0 = acc[ai][bj][m][0] + bv[bj][0], v1 = acc[ai][bj][m][1] + bv[bj][1];
                    u32x4 w; w.x = cvt_pk_bf16(v0[0], v0[1]); w.y = cvt_pk_bf16(v0[2], v0[3]); w.z = cvt_pk_bf16(v1[0], v1[1]); w.w = cvt_pk_bf16(v1[2], v1[3]);
                    *(u32x4*)(rowp + bj * HALF) = w; } }
    }
};
template <bool BASE_F32> struct EpiRes {
    static constexpr bool PERM = false, AFTER_DRAIN = false;
    float* Y; const float* bias; const float* x; const float* meta; const bf16_t* xb; float alpha;
    __device__ __forceinline__ void one(int row, int col, float v) const {
        float bs;
        if (BASE_F32) bs = (row < 16384 ? x + (size_t)row * 1024 : meta + (size_t)((row - 16384) & 15) * 1024)[col];
        else bs = __uint_as_float(((unsigned)xb[(size_t)row * 1024 + col]) << 16);
        Y[(size_t)row * 1024 + col] = v + bias[col] + bs * alpha; }
    __device__ __forceinline__ void operator()(const f32x4 (&acc)[2][2][4][2], const Unit& u, int wr, int wc, int fr, int fq) const {
        const int row0 = u.pm * BM + wr * 64 + fr, col0 = u.pn * BM + wc * 32 + 4 * fq;
        f32x4 bv[2][2];
#pragma unroll
        for (int bj = 0; bj < 2; ++bj)
#pragma unroll
            for (int n = 0; n < 2; ++n) bv[bj][n] = *(const f32x4*)(bias + col0 + bj * HALF + n * 16);
#pragma unroll
        for (int ai = 0; ai < 2; ++ai)
#pragma unroll
            for (int m = 0; m < 4; ++m) { const int row = row0 + ai * HALF + m * 16; float* rowp = Y + (size_t)row * 1024 + col0;
                if (BASE_F32) { const float* bp = (row < 16384 ? x + (size_t)row * 1024 : meta + (size_t)((row - 16384) & 15) * 1024) + col0;
#pragma unroll
                    for (int bj = 0; bj < 2; ++bj)
#pragma unroll
                        for (int n = 0; n < 2; ++n) { const f32x4 b = *(const f32x4*)(bp + bj * HALF + n * 16); *(f32x4*)(rowp + bj * HALF + n * 16) = acc[ai][bj][m][n] + bv[bj][n] + b * alpha; }
                } else { const bf16_t* bp = xb + (size_t)row * 1024 + col0;
#pragma unroll
                    for (int bj = 0; bj < 2; ++bj)
#pragma unroll
                        for (int n = 0; n < 2; ++n) { const uint2 b = *(const uint2*)(bp + bj * HALF + n * 16); const f32x4 bf = (f32x4){bf_lo(b.x), bf_hi(b.x), bf_lo(b.y), bf_hi(b.y)};
                            *(f32x4*)(rowp + bj * HALF + n * 16) = acc[ai][bj][m][n] + bv[bj][n] + bf * alpha; } }
                asm volatile("" ::: "memory"); }
    }
};


template <int CTRL> __device__ __forceinline__ float dppf(float x) { return __builtin_bit_cast(float, __builtin_amdgcn_mov_dpp(__builtin_bit_cast(int, x), CTRL, 0xf, 0xf, true)); }
__device__ __forceinline__ float silu_fast(float x) { return x * __builtin_amdgcn_rcpf(1.0f + __expf(-x)); }
struct EpiAct {
    static constexpr bool PERM = true, AFTER_DRAIN = false;
    bf16_t* ACT; const float* bias; const float* cw; const float* cb; float* SG; float* SP; float* SV; float* UM;
    __device__ __forceinline__ void one(int row, int col, float v) const { UM[(size_t)(row - 16384) * 5632 + col] = v + bias[col]; }
    __device__ __forceinline__ void operator()(const f32x4 (&acc)[2][2][4][2], const Unit& u, int wr, int wc, int fr, int fq) const {
        const int ch0 = 128 * u.pn + 32 * wc + 8 * fq, colg = 256 * u.pn + 32 * wc + 8 * fq;
#pragma unroll
        for (int ai = 0; ai < 2; ++ai) {
            const int rb = u.pm * BM + ai * HALF + wr * 64;
            uint2 pk[4];
#pragma unroll
            for (int n = 0; n < 2; ++n) {
                const f32x4 bgv = *(const f32x4*)(bias + colg + 4 * n), bvv = *(const f32x4*)(bias + colg + 128 + 4 * n);
                const f32x4 w0 = *(const f32x4*)(cw + ch0 + 4 * n), w1 = *(const f32x4*)(cw + 2816 + ch0 + 4 * n), w2 = *(const f32x4*)(cw + 5632 + ch0 + 4 * n), cbv = *(const f32x4*)(cb + ch0 + 4 * n);
                f32x4 g[4], ru[4], rd[4];
#pragma unroll
                for (int m = 0; m < 4; ++m) { g[m] = acc[ai][0][m][n] + bgv;
#pragma unroll
                    for (int e = 0; e < 4; ++e) { ru[m][e] = dppf<0x121>(g[m][e]); rd[m][e] = dppf<0x12F>(g[m][e]); } }
#pragma unroll
                for (int m = 0; m < 4; ++m) {
                    const f32x4 z = (f32x4){0.f, 0.f, 0.f, 0.f};
                    const f32x4 up = (fr == 0) ? (m > 0 ? ru[m > 0 ? m - 1 : 0] : z) : ru[m];
                    const f32x4 dn = (fr == 15) ? (m < 3 ? rd[m < 3 ? m + 1 : 3] : z) : rd[m];
                    const f32x4 cv = w0 * up + w1 * g[m] + w2 * dn + cbv;
                    const f32x4 v = acc[ai][1][m][n] + bvv;
                    f32x4 o;
#pragma unroll
                    for (int e = 0; e < 4; ++e) o[e] = silu_fast(cv[e]) * v[e];
                    const uint2 w = make_uint2(cvt_pk_bf16(o[0], o[1]), cvt_pk_bf16(o[2], o[3]));
                    if (n == 0) pk[m] = w;
                    else { u32x4 st; st.x = pk[m].x; st.y = pk[m].y; st.z = w.x; st.w = w.y; *(u32x4*)(ACT + (size_t)(rb + 16 * m + fr) * 2816 + ch0) = st; }
                    if ((m == 0 && fr == 0) || (m == 3 && fr == 15)) { const size_t so = (size_t)(2 * (rb >> 6) + (m == 3 ? 1 : 0)) * 2816 + ch0 + 4 * n;
                        *(f32x4*)(SG + so) = g[m]; *(f32x4*)(SP + so) = cv; *(f32x4*)(SV + so) = v; }
                }
            }
        }
    }
};
template <class Epi, class Sched, bool STAMP = false>
__device__ __forceinline__ void gemm_phase(PG8_LAS unsigned char* lds, const Gemm g, const Sched& S, const Epi& E, unsigned long long* stamps) {
    int tid = threadIdx.x; asm volatile("" : "+v"(tid));
    const int wid = __builtin_amdgcn_readfirstlane(tid >> 6), lane = tid & 63, wr = wid >> 2, wc = wid & 3, fr = lane & 15, fq = lane >> 4;
    const int K = g.K, nt = K / BK;
    int ts_lo = 0, ts_hi = 0, nts = 0; const unsigned long long rt_entry = STAMP ? (unsigned long long)wall_clock64() : 0ull;
#define PG8_STAMP() do { if (STAMP && wid == 0 && nts < 64) { const unsigned long long _c = (unsigned long long)clock64(); \
        ts_lo = (lane == nts) ? (int)(unsigned)_c : ts_lo; ts_hi = (lane == nts) ? (int)(unsigned)(_c >> 32) : ts_hi; ++nts; } } while (0)
    PG8_STAMP();
    unsigned voffA[2], voffB[2];
#pragma unroll
    for (int i = 0; i < 2; ++i) { int R, C; stage_rc(tid * 16 + i * 8192, R, C); const int Rb = Epi::PERM ? ((R & ~31) + perm32(R & 31)) : R;
        voffA[i] = (unsigned)(R * K + C) * 2u; voffB[i] = (unsigned)(Rb * K + C) * 2u; }
    const size_t kstep = (size_t)(BK * 2);
    const size_t hstep = (size_t)HALF * K * 2;
    const size_t tstep = 2 * hstep;
    const unsigned ldsw = (unsigned)wid * 1024u;
    const int aoff = lds_byte(wr * 64 + fr, fq * 8), boff = lds_byte(wc * 32 + fr, fq * 8);
#define PG8_SA(b, h) (((b) * 2 + (h)) * HTB)
#define PG8_SB(b, h) ((4 + (b) * 2 + (h)) * HTB)
#define PG8_STAGE(bufoff, gbase, voff) do { _Pragma("unroll") for (int _i = 0; _i < 2; ++_i) \
        __builtin_amdgcn_global_load_lds((const unsigned*)((const char*)(gbase) + (voff)[_i]), (PG8_LAS unsigned*)(lds + (bufoff) + ldsw + _i * 8192), 16, 0, 0); } while (0)
#define PG8_LDA(dst, b, h) do { _Pragma("unroll") for (int m = 0; m < 4; ++m) _Pragma("unroll") for (int k = 0; k < 2; ++k) dst[m][k] = *(const PG8_LAS bf16x8*)(lds + PG8_SA(b, h) + aoff + m * 2048 + k * 1024); } while (0)
#define PG8_LDB(dst, b, h) do { _Pragma("unroll") for (int n = 0; n < 2; ++n) _Pragma("unroll") for (int k = 0; k < 2; ++k) dst[n][k] = *(const PG8_LAS bf16x8*)(lds + PG8_SB(b, h) + boff + n * 2048 + k * 1024); } while (0)
#define PG8_MMA(ai, bj, At, Bt) do { __builtin_amdgcn_s_setprio(1); _Pragma("unroll") for (int m = 0; m < 4; ++m) _Pragma("unroll") for (int n = 0; n < 2; ++n) _Pragma("unroll") for (int k = 0; k < 2; ++k) \
        acc[ai][bj][m][n] = __builtin_amdgcn_mfma_f32_16x16x32_bf16(Bt[n][k], At[m][k], acc[ai][bj][m][n], 0, 0, 0); __builtin_amdgcn_s_setprio(0); } while (0)
#define PG8_WAIT_V(n) asm volatile("s_waitcnt vmcnt(" #n ")" ::: "memory")
#define PG8_WAIT_L(n) asm volatile("s_waitcnt lgkmcnt(" #n ")" ::: "memory")
#define PG8_BAR __builtin_amdgcn_s_barrier()
#define PG8_SCHED __builtin_amdgcn_sched_barrier(0)
    Unit cur, nxt; int ui = 0;
    if (!S.next(0, cur)) return;
    f32x4 acc[2][2][4][2];
#pragma unroll
    for (int a = 0; a < 2; ++a)
#pragma unroll
        for (int b = 0; b < 2; ++b)
#pragma unroll
            for (int m = 0; m < 4; ++m)
#pragma unroll
                for (int n = 0; n < 2; ++n) acc[a][b][m][n] = (f32x4){0.f, 0.f, 0.f, 0.f};
    bf16x8 At[4][2], B0[2][2], B1[2][2];
    const char* cA = (const char*)g.A + (size_t)cur.pm * tstep; const char* cB = (const char*)g.Bt + (size_t)cur.pn * tstep;
    S.a_ready(cur);
    PG8_STAGE(PG8_SB(0, 0), cB, voffB); PG8_STAGE(PG8_SA(0, 0), cA, voffA); PG8_STAGE(PG8_SB(0, 1), cB + hstep, voffB); PG8_STAGE(PG8_SA(0, 1), cA + hstep, voffA);
    if (wr == 1) PG8_BAR;
    PG8_WAIT_V(4); PG8_BAR;
    PG8_STAGE(PG8_SB(1, 0), cB + kstep, voffB); PG8_STAGE(PG8_SA(1, 0), cA + kstep, voffA); PG8_STAGE(PG8_SB(1, 1), cB + hstep + kstep, voffB);
    PG8_WAIT_V(6); PG8_BAR;
    PG8_STAMP();
    for (;;) {
        const bool has_next = S.next(ui + 1, nxt);
        const char* nA = has_next ? (const char*)g.A + (size_t)nxt.pm * tstep : cA; const char* nB = has_next ? (const char*)g.Bt + (size_t)nxt.pn * tstep : cB;
#pragma unroll 1
        for (int t = 0; t < nt; t += 2) {
            const bool last = (t == nt - 2);
            const char* a1 = cA + (size_t)(t + 1) * kstep;
            const char* a2 = last ? nA : cA + (size_t)(t + 2) * kstep; const char* b2 = last ? nB : cB + (size_t)(t + 2) * kstep;
            const char* a3 = a2 + kstep; const char* b3 = b2 + kstep;
            if (last && has_next) S.a_ready(nxt);
            PG8_LDB(B0, 0, 0); PG8_SCHED; PG8_LDA(At, 0, 0); PG8_STAGE(PG8_SA(1, 1), a1 + hstep, voffA);
            PG8_WAIT_L(8); PG8_BAR; PG8_WAIT_L(0); PG8_MMA(0, 0, At, B0); PG8_BAR; PG8_SCHED;
            PG8_LDB(B1, 0, 1); PG8_STAGE(PG8_SB(0, 0), b2, voffB);
            PG8_BAR; PG8_WAIT_L(0); PG8_MMA(0, 1, At, B1); PG8_BAR;
            PG8_LDA(At, 0, 1); PG8_STAGE(PG8_SA(0, 0), a2, voffA);
            PG8_BAR; PG8_WAIT_L(0); PG8_MMA(1, 0, At, B0); PG8_BAR; PG8_SCHED;
            PG8_STAGE(PG8_SB(0, 1), b2 + hstep, voffB);
            PG8_WAIT_V(6); PG8_BAR; PG8_MMA(1, 1, At, B1); PG8_BAR;
            PG8_LDB(B0, 1, 0); PG8_SCHED; PG8_LDA(At, 1, 0); PG8_STAGE(PG8_SA(0, 1), a2 + hstep, voffA);
            PG8_WAIT_L(8); PG8_BAR; PG8_WAIT_L(0); PG8_MMA(0, 0, At, B0); PG8_BAR; PG8_SCHED;
            PG8_LDB(B1, 1, 1); PG8_STAGE(PG8_SB(1, 0), b3, voffB);
            PG8_BAR; PG8_WAIT_L(0); PG8_MMA(0, 1, At, B1); PG8_BAR;
            PG8_LDA(At, 1, 1); PG8_STAGE(PG8_SA(1, 0), a3, voffA);
            PG8_BAR; PG8_WAIT_L(0); PG8_MMA(1, 0, At, B0); PG8_BAR; PG8_SCHED;
            PG8_STAGE(PG8_SB(1, 1), b3 + hstep, voffB);
            PG8_WAIT_V(6); PG8_BAR; PG8_MMA(1, 1, At, B1); PG8_BAR;
        }
        PG8_STAMP();
        if constexpr (!Epi::AFTER_DRAIN) { E(acc, cur, wr, wc, fr, fq); S.done(cur); }
        PG8_STAMP();
        if (!has_next) break;
#pragma unroll
        for (int a = 0; a < 2; ++a)
#pragma unroll
            for (int b = 0; b < 2; ++b)
#pragma unroll
                for (int m = 0; m < 4; ++m)
#pragma unroll
                    for (int n = 0; n < 2; ++n) acc[a][b][m][n] = (f32x4){0.f, 0.f, 0.f, 0.f};
        cur = nxt; cA = nA; cB = nB; ++ui;
    }
    PG8_WAIT_V(0);
    if (wr == 0) PG8_BAR;
    PG8_BAR;
    if constexpr (Epi::AFTER_DRAIN) { E.fused(acc, cur, wr, wc, fr, fq, lds, wid, lane); S.done(cur); }
    PG8_STAMP();
    if (STAMP && wid == 0) { stamps[lane] = lane < nts ? (((unsigned long long)(unsigned)ts_hi << 32) | (unsigned)ts_lo) : 0ull;
        if (lane == 62) stamps[62] = rt_entry; if (lane == 63) stamps[63] = (unsigned long long)wall_clock64(); }
#undef PG8_STAMP
#undef PG8_SA
#undef PG8_SB
#undef PG8_STAGE
#undef PG8_LDA
#undef PG8_LDB
#undef PG8_MMA
#undef PG8_WAIT_V
#undef PG8_WAIT_L
#undef PG8_BAR
#undef PG8_SCHED
}
}
#define LAS __attribute__((address_space(3)))
typedef pg8::bf16_t bf16_t;
typedef pg8::f32x4 f32x4;
constexpr int D = 1024, NB = 8, SEQ = 2048, NMETA = 16, LTOK = SEQ + NMETA;
constexpr int MMAIN = NB * SEQ, MMETA = NB * NMETA, MREAL = MMAIN + MMETA, MP = 16640;
constexpr int NINAB = 1536, NINC = 3072, DFF = 2816, NUP = 5632, HUP = 2816, HCH = 1408;
constexpr float ALPHA = 1.41421356237309515f, LN_EPS = 1e-5f;
constexpr size_t MiB = 1u << 20;
constexpr size_t WS_BUP = 0;
constexpr size_t WS_W_INAB = 1 * MiB, WS_W_OUTAB = 4 * MiB, WS_W_INC = 6 * MiB, WS_W_OUTC = 12 * MiB, WS_W_UP = 14 * MiB, WS_W_DN = 36 * MiB;
constexpr size_t SZ_W_UP = (size_t)NUP * D * 2, SZ_W_DN = (size_t)D * DFF * 2;
constexpr size_t WS_R1 = 48 * MiB, WS_R2 = 146 * MiB, WS_END = 236 * MiB;
static_assert(WS_W_DN + 2 * SZ_W_DN <= WS_R1 && WS_R1 + (size_t)MP * 3072 * 2 <= WS_R2 && WS_R2 + (size_t)MP * DFF * 2 <= WS_END, "ws map");
constexpr size_t WS_BAR = 65536;
constexpr int LDS_BYTES = 147456, LDS_BARW = LDS_BYTES - 64;

__device__ __forceinline__ int row_of(int b, int t) { return t < NMETA ? MMAIN + b * NMETA + t : b * SEQ + (t - NMETA); }
__device__ __forceinline__ float sigmoidf_(float x) { return 1.0f / (1.0f + __expf(-x)); }
__device__ __forceinline__ float siluf_(float x) { return x / (1.0f + __expf(-x)); }
__device__ __forceinline__ unsigned f2bf(float f) { unsigned u = __float_as_uint(f); return (u + 0x7fffu + ((u >> 16) & 1u)) >> 16; }
__device__ __forceinline__ unsigned pk2(float lo, float hi) { return f2bf(lo) | (f2bf(hi) << 16); }
__device__ __forceinline__ float bflo(unsigned w) { return __uint_as_float(w << 16); }
__device__ __forceinline__ float bfhi(unsigned w) { return __uint_as_float(w & 0xffff0000u); }
__device__ __forceinline__ float bf1(const bf16_t* p) { return __uint_as_float(((unsigned)*p) << 16); }
__device__ __forceinline__ float wave_sum(float v) {
#pragma unroll
    for (int o = 1; o < 64; o <<= 1) v += __shfl_xor(v, o);
    return v;
}
__device__ __forceinline__ int opaque_tid() { int t = threadIdx.x; asm volatile("" : "+v"(t)); return t; }
__device__ __forceinline__ int opaque_bid() { int t = blockIdx.x; asm volatile("" : "+s"(t)); return t; }
#define UNPACK8(v, f) do { f[0] = bflo(v.x); f[1] = bfhi(v.x); f[2] = bflo(v.y); f[3] = bfhi(v.y); f[4] = bflo(v.z); f[5] = bfhi(v.z); f[6] = bflo(v.w); f[7] = bfhi(v.w); } while (0)

struct Args { const float* in[28]; float* out; unsigned char* ws; };
enum { I_X = 0, I_META, I_W_IN_AB, I_B_IN_AB, I_CONV_A_W, I_CONV_A_B, I_NORM_A_G, I_NORM_A_B, I_POOL_W, I_POOL_SCALE, I_W_OUT_AB, I_B_OUT_AB, I_W_IN_C, I_B_IN_C, I_CONV_C_W, I_CONV_C_B,
       I_W_OUT_C, I_B_OUT_C, I_MIX_LN_G, I_MIX_LN_B, I_FFN_W_UP, I_FFN_B_UP, I_FFN_CONV_W, I_FFN_CONV_B, I_FFN_W_DOWN, I_FFN_B_DOWN, I_FFN_LN_G, I_FFN_LN_B };

#define XB_TMO      128
#define XB_XCNT(j)  (256  + 64 * (j))
#define XB_XSUB(j)  (1280 + 64 * (j))
#define XB_XGEN(j)  (2304 + 64 * (j))
#define XB_TOP      3328
#define XB_TOPGEN   3392
#define XCD_BAR_WORDS 3456
#define XB_SPIN_CAP (1u << 18)

__device__ __forceinline__ unsigned xb_ld(unsigned* p)              { return __hip_atomic_load(p, __ATOMIC_RELAXED, __HIP_MEMORY_SCOPE_AGENT); }
__device__ __forceinline__ unsigned xb_add(unsigned* p, unsigned v) { return __hip_atomic_fetch_add(p, v, __ATOMIC_RELAXED, __HIP_MEMORY_SCOPE_AGENT); }
__device__ __forceinline__ unsigned xb_xcc_id() { return (unsigned)__builtin_amdgcn_s_getreg((3 << 11) | 20) & 0xFu; }
#define XB_SPIN(cond, bar) do { unsigned _sp = 0; while (cond) { __builtin_amdgcn_s_sleep(1); \
    if ((++_sp & 255u) == 0u) { if (xb_ld(&(bar)[XB_TMO])) break; if (_sp > XB_SPIN_CAP) { atomicAdd(&(bar)[XB_TMO], 1u); break; } } } } while (0)

struct XcdBarrier {
    unsigned* bar; unsigned x;
    volatile LAS unsigned* st;
};

__device__ __forceinline__ XcdBarrier xcd_barrier_post(unsigned* bar, volatile LAS unsigned* st) {
    XcdBarrier b; b.bar = bar; b.x = xb_xcc_id(); b.st = st;
    if (threadIdx.x == 0) (void)xb_add(&bar[XB_XCNT(b.x)], 1u);
    return b;
}
__device__ __forceinline__ void xcd_barrier_complete(unsigned* bar, unsigned x, unsigned& nloc, unsigned& nx) {
    const unsigned G = gridDim.x * gridDim.y * gridDim.z;
    unsigned sum, cnt, mine, sp = 0u;
    for (;;) {
        sum = 0u; cnt = 0u; mine = 0u;
#pragma unroll
        for (unsigned j = 0; j < 16; ++j) { const unsigned c = xb_ld(&bar[XB_XCNT(j)]); sum += c; cnt += (c > 0u) ? 1u : 0u; mine = (j == x) ? c : mine; }
        if (sum == G) break;
        __builtin_amdgcn_s_sleep(1);
        if ((++sp & 255u) == 0u) { if (xb_ld(&bar[XB_TMO])) break; if (sp > XB_SPIN_CAP) { atomicAdd(&bar[XB_TMO], 1u); break; } }
    }
    nloc = mine > 0u ? mine : 1u; nx = cnt > 0u ? cnt : 1u;
}

__device__ __forceinline__ void xcd_barrier(const XcdBarrier& b) {
    asm volatile("s_waitcnt vmcnt(0)" ::: "memory");
    __syncthreads();
    if (threadIdx.x == 0) {
        unsigned* bar = b.bar;
        __builtin_amdgcn_s_waitcnt(0);
        unsigned nloc = b.st[0], nx = b.st[1];
        if (nloc == 0u) { xcd_barrier_complete(bar, b.x, nloc, nx); b.st[0] = nloc; b.st[1] = nx; }
        const unsigned old = xb_add(&bar[XB_XSUB(b.x)], 1u);
        const unsigned gen = old / nloc;
        if (old + 1u == (gen + 1u) * nloc) {
            __builtin_amdgcn_fence(__ATOMIC_RELEASE, "agent");
            asm volatile("s_waitcnt vmcnt(0)" ::: "memory");
            const unsigned og = xb_add(&bar[XB_TOP], 1u);
            const unsigned tg = og / nx;
            if (og + 1u == (tg + 1u) * nx) xb_add(&bar[XB_TOPGEN], 1u);
            else XB_SPIN(xb_ld(&bar[XB_TOPGEN]) == tg, bar);
            __builtin_amdgcn_fence(__ATOMIC_ACQUIRE, "agent");
            xb_add(&bar[XB_XGEN(b.x)], 1u);
            asm volatile("s_waitcnt vmcnt(0)" ::: "memory");
        } else {
            XB_SPIN(xb_ld(&bar[XB_XGEN(b.x)]) == gen, bar);
            __builtin_amdgcn_fence(__ATOMIC_ACQUIRE, "agent");
            asm volatile("s_waitcnt vmcnt(0)" ::: "memory");
        }
    }
    __syncthreads();
}


template <int NKS, class Epi> __device__ __forceinline__ void skinny_gemm(LAS unsigned char* lds, const bf16_t* A, const bf16_t* Bt, int N, const Epi& E) {
    typedef pg8::bf16x8 bf16x8;
    constexpr int K = NKS * 256;
    const int tid = opaque_tid(), lane = tid & 63, wave = tid >> 6, fr = lane & 15, fq = lane >> 4, G = gridDim.x, c = G - 1 - opaque_bid();
    const int nitems = 4 * (N >> 4);
    LAS f32x4* red = (LAS f32x4*)lds;
    for (int item = c; item < nitems; item += G) {
        const int rb = item & 3, cgp = item >> 2;
        const bf16_t* ap = A + (size_t)(MMAIN + 32 * rb + fr) * K + wave * (K / 8) + 8 * fq;
        const bf16_t* bp = Bt + (size_t)(16 * cgp + fr) * K + wave * (K / 8) + 8 * fq;
        bf16x8 a0[NKS], a1[NKS], bb[NKS];
#pragma unroll
        for (int s = 0; s < NKS; ++s) { a0[s] = *(const bf16x8*)(ap + 32 * s); a1[s] = *(const bf16x8*)(ap + (size_t)16 * K + 32 * s); bb[s] = *(const bf16x8*)(bp + 32 * s); }
        f32x4 acc0 = (f32x4){0.f, 0.f, 0.f, 0.f}, acc1 = acc0;
#pragma unroll
        for (int s = 0; s < NKS; ++s) { acc0 = __builtin_amdgcn_mfma_f32_16x16x32_bf16(bb[s], a0[s], acc0, 0, 0, 0); acc1 = __builtin_amdgcn_mfma_f32_16x16x32_bf16(bb[s], a1[s], acc1, 0, 0, 0); }
        __syncthreads();
        red[(wave * 2 + 0) * 64 + lane] = acc0; red[(wave * 2 + 1) * 64 + lane] = acc1;
        __syncthreads();
        { const int p = tid >> 2, e = tid & 3; const LAS float* rf = (const LAS float*)lds; float s = 0.f;
#pragma unroll
          for (int w = 0; w < 8; ++w) s += rf[((w * 2 + (p >> 6)) * 64 + (p & 63)) * 4 + e];
          const int pl = p & 63; E.one(MMAIN + 32 * rb + 16 * (p >> 6) + (pl & 15), 16 * cgp + 4 * (pl >> 4) + e, s); }
    }
    __syncthreads();
}

__device__ __forceinline__ void transpose_item(const float* W, int ldw, int k0, int n0, bf16_t* dst, int ldo, LAS float* scr, int lane) {
#pragma unroll 8
    for (int i = 0; i < 32; ++i) { const int kk = 2 * i + (lane >> 5); scr[kk * 33 + (lane & 31)] = W[(size_t)(k0 + kk) * ldw + n0 + (lane & 31)]; }
    asm volatile("s_waitcnt lgkmcnt(0)" ::: "memory");
    const int c = lane & 7;
#pragma unroll
    for (int j = 0; j < 4; ++j) { const int n = (lane >> 3) + 8 * j; const LAS float* s = scr + (8 * c) * 33 + n;
        uint4 o; o.x = pk2(s[0 * 33], s[1 * 33]); o.y = pk2(s[2 * 33], s[3 * 33]); o.z = pk2(s[4 * 33], s[5 * 33]); o.w = pk2(s[6 * 33], s[7 * 33]);
        *(uint4*)(dst + (size_t)n * ldo + 8 * c) = o; }
    asm volatile("s_waitcnt lgkmcnt(0)" ::: "memory");
}
__device__ __forceinline__ void phase_prep(const Args& a, LAS unsigned char* lds) {
    const int tid = opaque_tid(), lane = tid & 63, wave = tid >> 6, bid = opaque_bid();
    const int gw = bid * 8 + wave, NGW = gridDim.x * 8;
    unsigned char* ws = a.ws;
    LAS float* scr = (LAS float*)(lds + wave * 16384);
    bf16_t* W_INAB = (bf16_t*)(ws + WS_W_INAB); bf16_t* W_OUTAB = (bf16_t*)(ws + WS_W_OUTAB); bf16_t* W_INC = (bf16_t*)(ws + WS_W_INC); bf16_t* W_OUTC = (bf16_t*)(ws + WS_W_OUTC);
    constexpr int N1 = 16 * 48, N2 = 8 * 32, N3 = 16 * 96, N4 = 16 * 32, N5 = 16 * 176, N6 = 44 * 32;
    constexpr int NITEMS = N1 + N2 + N3 + N4 + 2 * N5 + 2 * N6;
    for (int it = gw; it < NITEMS; it += NGW) {
        int r = it;
        if (r < N1) { const int kb = r / 48, nb = r % 48; transpose_item(a.in[I_W_IN_AB], NINAB, 64 * kb, 32 * nb, W_INAB + (size_t)(32 * nb) * D + 64 * kb, D, scr, lane); continue; } r -= N1;
        if (r < N2) { const int kb = r / 32, nb = r % 32; transpose_item(a.in[I_W_OUT_AB], D, 64 * kb, 32 * nb, W_OUTAB + (size_t)(32 * nb) * D + 64 * kb, D, scr, lane); continue; } r -= N2;
        if (r < N3) { const int kb = r / 96, nb = r % 96; transpose_item(a.in[I_W_IN_C], NINC, 64 * kb, 32 * nb, W_INC + (size_t)(32 * nb) * D + 64 * kb, D, scr, lane); continue; } r -= N3;
        if (r < N4) { const int kb = r / 32, nb = r % 32; transpose_item(a.in[I_W_OUT_C], D, 64 * kb, 32 * nb, W_OUTC + (size_t)(32 * nb) * D + 64 * kb, D, scr, lane); continue; } r -= N4;
        if (r < 2 * N5) { const int l = r / N5; r -= l * N5; const int kb = r / 176, nb = r % 176; const int n0 = 32 * nb;
            const int ch = n0 < DFF ? n0 : n0 - DFF; const int orow = 256 * (ch >> 7) + (n0 < DFF ? 0 : 128) + (ch & 127);
            transpose_item(a.in[I_FFN_W_UP] + (size_t)l * D * NUP, NUP, 64 * kb, n0, (bf16_t*)(ws + WS_W_UP + l * SZ_W_UP) + (size_t)orow * D + 64 * kb, D, scr, lane); continue; } r -= 2 * N5;
        { const int l = r / N6; r -= l * N6; const int kb = r / 32, nb = r % 32;
            transpose_item(a.in[I_FFN_W_DOWN] + (size_t)l * DFF * D, D, 64 * kb, 32 * nb, (bf16_t*)(ws + WS_W_DN + l * SZ_W_DN) + (size_t)(32 * nb) * DFF + 64 * kb, DFF, scr, lane); }
    }
    { const float* pw = a.in[I_POOL_W]; const float* ps = a.in[I_POOL_SCALE]; const float* wo = a.in[I_W_OUT_AB];
      for (int idx = bid * 512 + tid; idx < 1024 * 512; idx += gridDim.x * 512) { const int kq = idx & 511, n = idx >> 9, g = kq >> 7;
          const float* pr = pw + (size_t)kq * 128; float s = 0.f;
#pragma unroll 8
          for (int d = 0; d < 128; ++d) s += pr[d] * (ps[g * 128 + d] * wo[(size_t)(512 + g * 128 + d) * D + n]);
          W_OUTAB[(size_t)n * D + 512 + kq] = (bf16_t)f2bf(s); } }
    { float* bup = (float*)(ws + WS_BUP);
      for (int idx = bid * 512 + tid; idx < 2 * NUP; idx += gridDim.x * 512) { const int l = idx / NUP, c = idx % NUP, j = c >> 8, bj = (c >> 7) & 1, i = c & 127;
          bup[idx] = a.in[I_FFN_B_UP][l * NUP + (bj ? DFF : 0) + 128 * j + i]; } }
    { bf16_t* XB = (bf16_t*)a.out;
      for (int m = gw; m < MP; m += NGW) { uint2* o8 = (uint2*)(XB + (size_t)m * D) + lane;
          if (m < MREAL) { const float* src = m < MMAIN ? a.in[I_X] + (size_t)m * D : a.in[I_META] + (size_t)((m - MMAIN) & 15) * D; const f32x4* xr = (const f32x4*)src + lane;
#pragma unroll
              for (int j = 0; j < 4; ++j) { const f32x4 v = xr[64 * j]; o8[64 * j] = make_uint2(pk2(v.x, v.y), pk2(v.z, v.w)); } }
          else {
#pragma unroll
              for (int j = 0; j < 4; ++j) o8[64 * j] = make_uint2(0u, 0u); } } }
}

__device__ __forceinline__ void phase_mixer0(const Args& a, LAS unsigned char* lds, const bf16_t* Hab, bf16_t* AP) {
    constexpr int T = 34, NT = 61;
    const int tid = opaque_tid(), lane = tid & 63, wave = tid >> 6, bid = opaque_bid();
    LAS float* la = (LAS float*)lds;
    LAS float* part = (LAS float*)(lds + 131072);
    LAS float* stat = (LAS float*)(lds + 131072 + 2304);
    float w[31];
#pragma unroll
    for (int j = 0; j < 31; ++j) w[j] = a.in[I_CONV_A_W][j * 512 + tid];
    const float cb = a.in[I_CONV_A_B][tid], ng = a.in[I_NORM_A_G][tid], nbb = a.in[I_NORM_A_B][tid];
    for (int item = bid; item < NB * NT; item += gridDim.x) {
        const int b = item / NT, t0 = (item % NT) * T;
        __syncthreads();
#pragma unroll
        for (int i = 0; i < 8; ++i) { const int q = tid + 512 * i, j = q >> 6, c8 = q & 63, pos = t0 - 15 + j;
            float av[8];
#pragma unroll
            for (int e = 0; e < 8; ++e) av[e] = 0.f;
            if (pos >= 0 && pos < LTOK) { const bf16_t* rp = Hab + (size_t)row_of(b, pos) * NINAB + 8 * c8; const uint4 vv = *(const uint4*)rp, gg = *(const uint4*)(rp + 512);
                float fv[8], fg[8]; UNPACK8(vv, fv); UNPACK8(gg, fg);
#pragma unroll
                for (int e = 0; e < 8; ++e) av[e] = fv[e] * sigmoidf_(fg[e]); }
            LAS f32x4* dst = (LAS f32x4*)(la + j * 512 + 8 * c8); dst[0] = (f32x4){av[0], av[1], av[2], av[3]}; dst[1] = (f32x4){av[4], av[5], av[6], av[7]}; }
        __syncthreads();
        float o[T];
#pragma unroll
        for (int p = 0; p < T; ++p) { float acc = cb;
#pragma unroll
            for (int j = 0; j < 31; ++j) acc += w[j] * la[(p + j) * 512 + tid];
            o[p] = acc; }
#pragma unroll
        for (int p = 0; p < T; ++p) { const float s1 = wave_sum(o[p]), s2 = wave_sum(o[p] * o[p]); if (lane == 0) { part[(p * 8 + wave) * 2] = s1; part[(p * 8 + wave) * 2 + 1] = s2; } }
        __syncthreads();
        if (tid < T) { float s1 = 0.f, s2 = 0.f;
#pragma unroll
            for (int k = 0; k < 8; ++k) { s1 += part[(tid * 8 + k) * 2]; s2 += part[(tid * 8 + k) * 2 + 1]; }
            const float mean = s1 * (1.f / 512.f); float var = s2 * (1.f / 512.f) - mean * mean; var = var > 0.f ? var : 0.f;
            stat[2 * tid] = mean; stat[2 * tid + 1] = 1.0f / sqrtf(var + LN_EPS); }
        __syncthreads();
#pragma unroll
        for (int p = 0; p < T; ++p) { const int t = t0 + p;
            if (t < LTOK) { const float y = (o[p] - stat[2 * p]) * stat[2 * p + 1] * ng + nbb; AP[(size_t)row_of(b, t) * D + tid] = (bf16_t)f2bf(siluf_(y)); } }
        { const int half = 1 << (tid >> 7); const bf16_t* U = Hab + 1024 + tid;
          const int tend = (t0 + T < LTOK) ? t0 + T : LTOK;
          int lo = t0 - half; lo = lo < 0 ? 0 : lo; int hi = t0 + half; hi = hi > LTOK ? LTOK : hi;
          float s = 0.f;
          for (int q = lo; q < hi; ++q) s += bf1(U + (size_t)row_of(b, q) * NINAB);
          for (int t = t0; t < tend; ++t) {
              int l2 = t - half; l2 = l2 < 0 ? 0 : l2; int h2 = t + half; h2 = h2 > LTOK ? LTOK : h2;
              const float ut = bf1(U + (size_t)row_of(b, t) * NINAB);
              AP[(size_t)row_of(b, t) * D + 512 + tid] = (bf16_t)f2bf(s / (float)(h2 - l2) - ut);
              if (t + half < LTOK) s += bf1(U + (size_t)row_of(b, t + half) * NINAB);
              if (t - half >= 0) s -= bf1(U + (size_t)row_of(b, t - half) * NINAB);
          } }
    }
}

__device__ __forceinline__ void phase_act(const Args& a, const bf16_t* U, bf16_t* ACT, int l, int h) {
    const float* cw = a.in[I_FFN_CONV_W] + (size_t)l * 3 * DFF; const float* cbp = a.in[I_FFN_CONV_B] + (size_t)l * DFF;
    const int nth = gridDim.x * 512;
    for (int idx = opaque_bid() * 512 + opaque_tid(); idx < MREAL * 176; idx += nth) {
        const int r = idx / 176, q = idx - r * 176, b = r / LTOK, t = r - b * LTOK;
        const int jt = q >> 4, i8 = (q & 15) * 8, gcol = 256 * jt + i8, ch = HCH * h + 128 * jt + i8;
        const int row = row_of(b, t);
        const bf16_t* up = U + (size_t)row * HUP + gcol;
        const uint4 g0v = *(const uint4*)up, vv = *(const uint4*)(up + 128);
        uint4 gmv = make_uint4(0, 0, 0, 0), gpv = make_uint4(0, 0, 0, 0);
        if (t > 0) gmv = *(const uint4*)(U + (size_t)row_of(b, t - 1) * HUP + gcol);
        if (t < LTOK - 1) gpv = *(const uint4*)(U + (size_t)row_of(b, t + 1) * HUP + gcol);
        float g0[8], gm[8], gp[8], v[8]; UNPACK8(g0v, g0); UNPACK8(gmv, gm); UNPACK8(gpv, gp); UNPACK8(vv, v);
        float w0[8], w1[8], w2[8], cb[8];
        *(f32x4*)&w0[0] = *(const f32x4*)(cw + ch); *(f32x4*)&w0[4] = *(const f32x4*)(cw + ch + 4);
        *(f32x4*)&w1[0] = *(const f32x4*)(cw + DFF + ch); *(f32x4*)&w1[4] = *(const f32x4*)(cw + DFF + ch + 4);
        *(f32x4*)&w2[0] = *(const f32x4*)(cw + 2 * DFF + ch); *(f32x4*)&w2[4] = *(const f32x4*)(cw + 2 * DFF + ch + 4);
        *(f32x4*)&cb[0] = *(const f32x4*)(cbp + ch); *(f32x4*)&cb[4] = *(const f32x4*)(cbp + ch + 4);
        float o[8];
#pragma unroll
        for (int e = 0; e < 8; ++e) o[e] = siluf_(w0[e] * gm[e] + w1[e] * g0[e] + w2[e] * gp[e] + cb[e]) * v[e];
        uint4 ov; ov.x = pk2(o[0], o[1]); ov.y = pk2(o[2], o[3]); ov.z = pk2(o[4], o[5]); ov.w = pk2(o[6], o[7]);
        *(uint4*)(ACT + (size_t)row * DFF + ch) = ov;
    }
}


__device__ __forceinline__ float silu4(float x) { return x * __builtin_amdgcn_rcpf(1.0f + __expf(-x)); }
__device__ __forceinline__ void phase_fixup(const Args& a, int l, const float* SG, const float* SP, const float* SV, const float* UM, bf16_t* ACT) {
    const float* cw = a.in[I_FFN_CONV_W] + (size_t)l * 3 * DFF; const float* cbp = a.in[I_FFN_CONV_B] + (size_t)l * DFF;
    const int nth = gridDim.x * 512, gt = opaque_bid() * 512 + opaque_tid();
    for (int idx = gt; idx < 512 * 704; idx += nth) {
        const int s = idx / 704, ch = (idx - s * 704) * 4, k = s >> 1, side = s & 1, row = 64 * k + 63 * side;
        const f32x4 p = *(const f32x4*)(SP + (size_t)s * DFF + ch), v = *(const f32x4*)(SV + (size_t)s * DFF + ch);
        f32x4 gn = (f32x4){0.f, 0.f, 0.f, 0.f}, w;
        if (side == 0) { w = *(const f32x4*)(cw + ch);
            if ((row & 2047) == 0) gn = *(const f32x4*)(UM + (size_t)((row >> 11) * 16 + 15) * NUP + 256 * (ch >> 7) + (ch & 127));
            else gn = *(const f32x4*)(SG + (size_t)(s - 1) * DFF + ch); }
        else { w = *(const f32x4*)(cw + 2 * DFF + ch);
            if ((row & 2047) != 2047) gn = *(const f32x4*)(SG + (size_t)(s + 1) * DFF + ch); }
        const f32x4 cv = p + w * gn;
        *(uint2*)(ACT + (size_t)row * DFF + ch) = make_uint2(pk2(silu4(cv[0]) * v[0], silu4(cv[1]) * v[1]), pk2(silu4(cv[2]) * v[2], silu4(cv[3]) * v[3]));
    }
    for (int idx = gt; idx < 128 * 704; idx += nth) {
        const int mr = idx / 704, ch = (idx - mr * 704) * 4, b = mr >> 4, j = mr & 15, col = 256 * (ch >> 7) + (ch & 127);
        const f32x4 z = (f32x4){0.f, 0.f, 0.f, 0.f};
        const f32x4 g0 = *(const f32x4*)(UM + (size_t)mr * NUP + col), v = *(const f32x4*)(UM + (size_t)mr * NUP + col + 128);
        const f32x4 gu = j > 0 ? *(const f32x4*)(UM + (size_t)(mr - 1) * NUP + col) : z;
        const f32x4 gd = j < 15 ? *(const f32x4*)(UM + (size_t)(mr + 1) * NUP + col) : *(const f32x4*)(SG + (size_t)(2 * (b * 32)) * DFF + ch);
        const f32x4 cv = *(const f32x4*)(cw + ch) * gu + *(const f32x4*)(cw + DFF + ch) * g0 + *(const f32x4*)(cw + 2 * DFF + ch) * gd + *(const f32x4*)(cbp + ch);
        *(uint2*)(ACT + (size_t)(MMAIN + mr) * DFF + ch) = make_uint2(pk2(silu4(cv[0]) * v[0], silu4(cv[1]) * v[1]), pk2(silu4(cv[2]) * v[2], silu4(cv[3]) * v[3]));
    }
}

__device__ __forceinline__ void phase_yc(const Args& a, const bf16_t* Hc, bf16_t* YC) {
    const float* cw = a.in[I_CONV_C_W]; const float* cbp = a.in[I_CONV_C_B];
    const int nth = gridDim.x * 512;
    for (int idx = opaque_bid() * 512 + opaque_tid(); idx < MREAL * 128; idx += nth) {
        const int r = idx >> 7, c8 = (idx & 127) * 8, b = r / LTOK, t = r - b * LTOK;
        const int row = row_of(b, t);
        const bf16_t* hp = Hc + (size_t)row * NINC + c8;
        const uint4 bgv = *(const uint4*)hp, c0v = *(const uint4*)(hp + 1024), v0v = *(const uint4*)(hp + 2048);
        uint4 cmv = make_uint4(0, 0, 0, 0), vmv = cmv, cpv = cmv, vpv = cmv;
        if (t > 0) { const bf16_t* p = Hc + (size_t)row_of(b, t - 1) * NINC + c8; cmv = *(const uint4*)(p + 1024); vmv = *(const uint4*)(p + 2048); }
        if (t < LTOK - 1) { const bf16_t* p = Hc + (size_t)row_of(b, t + 1) * NINC + c8; cpv = *(const uint4*)(p + 1024); vpv = *(const uint4*)(p + 2048); }
        float bg[8], c0[8], v0[8], cm[8], vm[8], cp[8], vp[8];
        UNPACK8(bgv, bg); UNPACK8(c0v, c0); UNPACK8(v0v, v0); UNPACK8(cmv, cm); UNPACK8(vmv, vm); UNPACK8(cpv, cp); UNPACK8(vpv, vp);
        float w0[8], w1[8], w2[8], cb[8];
        *(f32x4*)&w0[0] = *(const f32x4*)(cw + c8); *(f32x4*)&w0[4] = *(const f32x4*)(cw + c8 + 4);
        *(f32x4*)&w1[0] = *(const f32x4*)(cw + D + c8); *(f32x4*)&w1[4] = *(const f32x4*)(cw + D + c8 + 4);
        *(f32x4*)&w2[0] = *(const f32x4*)(cw + 2 * D + c8); *(f32x4*)&w2[4] = *(const f32x4*)(cw + 2 * D + c8 + 4);
        *(f32x4*)&cb[0] = *(const f32x4*)(cbp + c8); *(f32x4*)&cb[4] = *(const f32x4*)(cbp + c8 + 4);
        float o[8];
#pragma unroll
        for (int e = 0; e < 8; ++e) o[e] = bg[e] * (w0[e] * (cm[e] * vm[e]) + w1[e] * (c0[e] * v0[e]) + w2[e] * (cp[e] * vp[e]) + cb[e]);
        uint4 ov; ov.x = pk2(o[0], o[1]); ov.y = pk2(o[2], o[3]); ov.z = pk2(o[4], o[5]); ov.w = pk2(o[6], o[7]);
        *(uint4*)(YC + (size_t)row * D + c8) = ov;
    }
}

template <bool FINAL> __device__ __forceinline__ void phase_ln(const float* Y, const float* g, const float* bta, bf16_t* XB, float* out) {
    const int tid = opaque_tid(), lane = tid & 63, wave = tid >> 6, gw = opaque_bid() * 8 + wave, NGW = gridDim.x * 8;
    asm volatile("" ::: "memory");
    const int nrows = FINAL ? MMAIN : MREAL;
    for (int m = gw; m < nrows; m += NGW) {
        const f32x4* yr = (const f32x4*)(Y + (size_t)m * D) + lane;
        f32x4 v[4]; float s = 0.f;
#pragma unroll
        for (int j = 0; j < 4; ++j) { v[j] = yr[64 * j]; s += (v[j].x + v[j].y) + (v[j].z + v[j].w); }
        const float mean = wave_sum(s) * (1.f / D); float s2 = 0.f;
#pragma unroll
        for (int j = 0; j < 4; ++j) { v[j] = v[j] - mean; s2 += (v[j].x * v[j].x + v[j].y * v[j].y) + (v[j].z * v[j].z + v[j].w * v[j].w); }
        const float rstd = 1.f / sqrtf(wave_sum(s2) * (1.f / D) + LN_EPS);
        if (FINAL) { f32x4* o = (f32x4*)(out + (size_t)m * D) + lane;
#pragma unroll
            for (int j = 0; j < 4; ++j) o[64 * j] = v[j] * rstd * ((const f32x4*)g)[lane + 64 * j] + ((const f32x4*)bta)[lane + 64 * j]; }
        else { uint2* o8 = (uint2*)(XB + (size_t)m * D) + lane;
#pragma unroll
            for (int j = 0; j < 4; ++j) { const f32x4 y = v[j] * rstd * ((const f32x4*)g)[lane + 64 * j] + ((const f32x4*)bta)[lane + 64 * j]; o8[64 * j] = make_uint2(pk2(y.x, y.y), pk2(y.z, y.w)); } }
    }
}

template <int NKS, class Epi> __device__ __forceinline__ void run_gemm(LAS unsigned char* lds, const bf16_t* A, const bf16_t* Bt, int N, int K, const Epi& E) {
    asm volatile("" : "+s"(N), "+s"(K));
    pg8::Gemm g{A, Bt, MMAIN, N, K}; pg8::StaticOrder S; S.init(MMAIN, N, (int)gridDim.x, opaque_bid());
    pg8::gemm_phase<Epi, pg8::StaticOrder, false>(lds, g, S, E, nullptr);
    skinny_gemm<NKS>(lds, A, Bt, N, E);
}

#ifndef NREP
#define NREP 1
#endif
#ifndef NXSYNC
#define NXSYNC 0
#endif
__global__ void __launch_bounds__(512, 2) fwd_kernel(Args a) {
    extern __shared__ __attribute__((aligned(16))) unsigned char lds_raw[];
    LAS unsigned char* lds = (LAS unsigned char*)lds_raw;
    cg::grid_group grid = cg::this_grid();
    unsigned char* ws = a.ws;
    if (ws == nullptr) grid.sync();
    if (threadIdx.x < 16) ((LAS unsigned*)(lds + LDS_BARW))[threadIdx.x] = 0u;
    __syncthreads();
    const XcdBarrier bar = xcd_barrier_post((unsigned*)(ws + WS_BAR), (volatile LAS unsigned*)(lds + LDS_BARW));
#define GRID_SYNC() xcd_barrier(bar)
    bf16_t* XB = (bf16_t*)a.out;
    bf16_t* R1b = (bf16_t*)(ws + WS_R1); float* Y = (float*)(ws + WS_R1); bf16_t* R2b = (bf16_t*)(ws + WS_R2);
    const float* bup = (const float*)(ws + WS_BUP);

#ifndef SKIP_PREP
    for (int rep = 0; rep < NREP; ++rep) phase_prep(a, lds);
    for (int rep = 0; rep < NXSYNC; ++rep) GRID_SYNC();
#endif
    GRID_SYNC();
    { pg8::EpiBf16 E{R1b, NINAB, a.in[I_B_IN_AB]}; run_gemm<4>(lds, XB, (const bf16_t*)(ws + WS_W_INAB), NINAB, D, E); }
    GRID_SYNC();
#ifndef SKIP_MIX
    for (int rep = 0; rep < NREP; ++rep) phase_mixer0(a, lds, R1b, R2b);
#endif
    GRID_SYNC();
    { pg8::EpiRes<true> E{Y, a.in[I_B_OUT_AB], a.in[I_X], a.in[I_META], XB, ALPHA}; run_gemm<4>(lds, R2b, (const bf16_t*)(ws + WS_W_OUTAB), D, D, E); }
    GRID_SYNC();
#ifndef SKIP_LN
    for (int rep = 0; rep < NREP; ++rep) phase_ln<false>(Y, a.in[I_MIX_LN_G], a.in[I_MIX_LN_B], XB, nullptr);
#endif
    GRID_SYNC();
#pragma unroll 1
    for (int l = 0; l < 2; ++l) {
        if (l == 1) {
            { pg8::EpiBf16 E{R1b, NINC, a.in[I_B_IN_C]}; run_gemm<4>(lds, XB, (const bf16_t*)(ws + WS_W_INC), NINC, D, E); }
            GRID_SYNC();
#ifndef SKIP_YC
            for (int rep = 0; rep < NREP; ++rep) phase_yc(a, R1b, R2b);
#endif
            GRID_SYNC();
            { pg8::EpiRes<false> E{Y, a.in[I_B_OUT_C], nullptr, nullptr, XB, ALPHA}; run_gemm<4>(lds, R2b, (const bf16_t*)(ws + WS_W_OUTC), D, D, E); }
            GRID_SYNC();
#ifndef SKIP_LN
            for (int rep = 0; rep < NREP; ++rep) phase_ln<false>(Y, a.in[I_MIX_LN_G] + D, a.in[I_MIX_LN_B] + D, XB, nullptr);
#endif
            GRID_SYNC();
        }
        { float* SG = (float*)(ws + WS_R1); float* SP = (float*)(ws + WS_R1 + 6 * MiB); float* SV = (float*)(ws + WS_R1 + 12 * MiB); float* UM = (float*)(ws + WS_R1 + 18 * MiB);
          { pg8::EpiAct E{R2b, bup + l * NUP, a.in[I_FFN_CONV_W] + (size_t)l * 3 * DFF, a.in[I_FFN_CONV_B] + (size_t)l * DFF, SG, SP, SV, UM};
            run_gemm<4>(lds, XB, (const bf16_t*)(ws + WS_W_UP + l * SZ_W_UP), NUP, D, E); }
          GRID_SYNC();
          phase_fixup(a, l, SG, SP, SV, UM, R2b);
          GRID_SYNC(); }
        { pg8::EpiRes<false> E{Y, a.in[I_FFN_B_DOWN] + l * D, nullptr, nullptr, XB, ALPHA}; run_gemm<11>(lds, R2b, (const bf16_t*)(ws + WS_W_DN + l * SZ_W_DN), D, DFF, E); }
        GRID_SYNC();
#ifndef SKIP_LN
        if (l == 0) { for (int rep = 0; rep < NREP; ++rep) phase_ln<false>(Y, a.in[I_FFN_LN_G], a.in[I_FFN_LN_B], XB, nullptr); GRID_SYNC(); }
        else for (int rep = 0; rep < NREP; ++rep) phase_ln<true>(Y, a.in[I_FFN_LN_G] + D, a.in[I_FFN_LN_B] + D, nullptr, a.out);
#endif
    }
}

extern "C" void kernel_launch(void* const* d_in, const int* in_sizes, int n_in, void* d_out, int out_size, void* d_ws, size_t ws_size, hipStream_t stream) {
    static int grid_blocks = 0;
    if (!grid_blocks) {
        if (n_in != 28 || out_size != MMAIN * D || ws_size < WS_END) { fprintf(stderr, "kernel_launch: unexpected shapes: n_in %d out %d ws %zu\n", n_in, out_size, ws_size); grid_blocks = -1; return; }
        int dev = 0, cus = 0, per_cu = 0;
        hipGetDevice(&dev);
        hipDeviceGetAttribute(&cus, hipDeviceAttributeMultiprocessorCount, dev);
        hipFuncSetAttribute((const void*)fwd_kernel, hipFuncAttributeMaxDynamicSharedMemorySize, LDS_BYTES);
        hipOccupancyMaxActiveBlocksPerMultiprocessor(&per_cu, (const void*)fwd_kernel, 512, LDS_BYTES);
        if (per_cu < 1) { fprintf(stderr, "kernel_launch: occupancy query says %d blocks per CU\n", per_cu); per_cu = 1; }
        (void)hipGetLastError();
        grid_blocks = cus;
    }
    if (grid_blocks < 0) return;
    Args a{};
    for (int i = 0; i < 28; ++i) a.in[i] = (const float*)d_in[i];
    a.out = (float*)d_out; a.ws = (unsigned char*)d_ws;
    (void)hipMemsetAsync((unsigned char*)d_ws + WS_BAR, 0, 16384, stream);
    void* args[] = {&a};
    hipError_t e = hipLaunchCooperativeKernel((const void*)fwd_kernel, dim3(grid_blocks), dim3(512), args, LDS_BYTES, stream);
    if (e != hipSuccess) fprintf(stderr, "cooperative launch failed: %s (grid %d)\n", hipGetErrorString(e), grid_blocks);
}
```
